# Optimizing an MI355X kernel written in HIP

```python
import jax, jax.numpy as jnp
from jax import lax
import numpy as np

D_MODEL = 1024
BATCH = 8
SEQ = 2048
DEPTH = 2

CHUNK = 128
RET_HEADS = 4
RET_QK_DIM = 128
RET_V_DIM = 256
RET_QK_WIDTH = RET_HEADS * RET_QK_DIM
RET_V_WIDTH = RET_HEADS * RET_V_DIM
GMLP_GROUPS = 4
GMLP_WIDTH = D_MODEL
GMLP_GROUP_DIM = GMLP_WIDTH // GMLP_GROUPS
POOL_WINDOWS = (2, 4, 8, 16)
POOL_GROUPS = 4
POOL_WIDTH = D_MODEL
POOL_GROUP_DIM = POOL_WIDTH // POOL_GROUPS
N_BRANCH = 3
BRANCH_WIDTH = D_MODEL
D_FF = 4 * D_MODEL
N_MOD = 6
ROPE_BASE = 10000.0
EPS = 1e-6
SPLITS = (RET_QK_WIDTH, RET_QK_WIDTH, RET_V_WIDTH, RET_V_WIDTH,
          GMLP_WIDTH, GMLP_WIDTH, POOL_WIDTH, N_BRANCH * D_MODEL)
D_IN = 2 * RET_QK_WIDTH + 2 * RET_V_WIDTH + 2 * GMLP_WIDTH + POOL_WIDTH + N_BRANCH * D_MODEL

kernel_name = "hybrid_retention_gmlp_pool_adaln"


def rms_norm(x, gain=None):
    xf = x.astype(jnp.float32)
    y = xf * lax.rsqrt(jnp.mean(xf * xf, axis=-1, keepdims=True) + EPS)
    if gain is not None:
        y = y * gain.astype(jnp.float32)
    return y.astype(x.dtype)


def split_columns(proj):
    pieces, start = [], 0
    for w in SPLITS:
        pieces.append(proj[..., start:start + w])
        start += w
    return pieces


def rotary(x, positions):
    half = x.shape[-1] // 2
    inv_freq = ROPE_BASE ** (-jnp.arange(half, dtype=jnp.float32) / half)
    ang = positions.astype(jnp.float32)[:, :, None] * inv_freq
    cos = jnp.cos(ang)[:, :, None, :]
    sin = jnp.sin(ang)[:, :, None, :]
    xf = x.astype(jnp.float32)
    x1, x2 = xf[..., :half], xf[..., half:]
    return jnp.concatenate([x1 * cos - x2 * sin, x2 * cos + x1 * sin], axis=-1).astype(x.dtype)


def retention(q, k, v, g, positions):
    B, S, _ = q.shape
    nc = S // CHUNK
    dt = q.dtype
    q = rotary(q.reshape(B, S, RET_HEADS, RET_QK_DIM), positions)
    k = rotary(k.reshape(B, S, RET_HEADS, RET_QK_DIM), positions) * (RET_QK_DIM ** -0.5)
    v = v.reshape(B, S, RET_HEADS, RET_V_DIM)
    log_gamma = jnp.log1p(-jnp.power(2.0, -5.0 - jnp.arange(RET_HEADS, dtype=jnp.float32)))
    pos = jnp.arange(CHUNK, dtype=jnp.float32)
    rel = pos[:, None] - pos[None, :]
    causal = rel >= 0
    decay_intra = jnp.where(causal[None],
                            jnp.exp(log_gamma[:, None, None] * jnp.where(causal, rel, 0.0)[None]),
                            0.0)
    decay_q = jnp.exp(log_gamma[:, None] * (pos + 1.0)[None])
    decay_k = jnp.exp(log_gamma[:, None] * (CHUNK - 1.0 - pos)[None])
    decay_chunk = jnp.exp(log_gamma * CHUNK)

    qc = q.reshape(B, nc, CHUNK, RET_HEADS, RET_QK_DIM)
    kc = k.reshape(B, nc, CHUNK, RET_HEADS, RET_QK_DIM)
    vc = v.reshape(B, nc, CHUNK, RET_HEADS, RET_V_DIM)
    scores = jnp.einsum('bnihd,bnjhd->bnhij', qc, kc) * decay_intra.astype(dt)
    intra = jnp.einsum('bnhij,bnjhe->bnihe', scores, vc)
    kv = jnp.einsum('bnjhd,hj,bnjhe->nbhde', kc, decay_k.astype(dt), vc).astype(jnp.float32)

    def step(state, kv_n):
        return decay_chunk[None, :, None, None] * state + kv_n, state

    _, prev = lax.scan(step, jnp.zeros((B, RET_HEADS, RET_QK_DIM, RET_V_DIM), jnp.float32), kv)
    cross = jnp.einsum('bnihd,hi,nbhde->bnihe', qc, decay_q.astype(dt), prev.astype(dt))
    o = (intra + cross).reshape(B, S, RET_HEADS, RET_V_DIM)
    o = rms_norm(o).reshape(B, S, RET_V_WIDTH)
    return jax.nn.silu(g) * o


def spatial_gating(u, v, w_s, b_s, v_gain):
    B, S, _ = u.shape
    nc = S // CHUNK
    u = jax.nn.gelu(u)
    v = rms_norm(jax.nn.gelu(v), v_gain)
    vc = v.reshape(B, nc, CHUNK, GMLP_GROUPS, GMLP_GROUP_DIM)
    mask = jnp.tril(jnp.ones((CHUNK, CHUNK), dtype=bool))
    w = jnp.where(mask[None], w_s, jnp.zeros_like(w_s))
    mixed = jnp.einsum('gts,bnsgc->bntgc', w, vc) + b_s.T[None, None, :, :, None]
    return u * mixed.reshape(B, S, GMLP_WIDTH)


def multiscale_pool(p, w_pool, b_pool, scale):
    B, S, _ = p.shape
    pg = p.reshape(B, S, POOL_GROUPS, POOL_GROUP_DIM).astype(jnp.float32)
    cs = jnp.concatenate([jnp.zeros((B, 1, POOL_GROUPS, POOL_GROUP_DIM), jnp.float32),
                          jnp.cumsum(pg, axis=1)], axis=1)
    t = jnp.arange(1, S + 1)
    outs = []
    for gi, w in enumerate(POOL_WINDOWS):
        start = jnp.maximum(t - w, 0)
        window_sum = cs[:, 1:, gi] - cs[:, start, gi]
        count = jnp.minimum(t, w).astype(jnp.float32)[None, :, None]
        outs.append(window_sum / count - pg[:, :, gi])
    pooled = jnp.stack(outs, axis=2).astype(p.dtype)
    mixed = jnp.einsum('bsgc,gce->bsge', pooled, w_pool) + b_pool[None, None]
    return mixed.reshape(B, S, POOL_WIDTH) * scale


def setup_inputs(seed: int = 0) -> dict:
    key = jax.random.key(seed)
    ks = jax.random.split(key, 20)
    f32 = jnp.float32
    nrm = lambda k, shape, s: jax.random.normal(k, shape, f32) * s
    return {
        "x": nrm(ks[0], (BATCH, SEQ, D_MODEL), 1.0),
        "c": nrm(ks[1], (BATCH, D_MODEL), 1.0),
        "positions": jnp.broadcast_to(jnp.arange(SEQ, dtype=jnp.int32), (BATCH, SEQ)),
        "w_ada": nrm(ks[2], (DEPTH, D_MODEL, N_MOD * D_MODEL), 0.5 * D_MODEL ** -0.5),
        "b_ada": nrm(ks[3], (DEPTH, N_MOD * D_MODEL), 0.01),
        "norm1": 1.0 + nrm(ks[4], (DEPTH, D_MODEL), 0.02),
        "norm2": 1.0 + nrm(ks[5], (DEPTH, D_MODEL), 0.02),
        "w_in": nrm(ks[6], (DEPTH, D_MODEL, D_IN), D_MODEL ** -0.5),
        "ws_gmlp": nrm(ks[7], (DEPTH, GMLP_GROUPS, CHUNK, CHUNK), CHUNK ** -0.5),
        "bs_gmlp": 1.0 + nrm(ks[8], (DEPTH, GMLP_GROUPS, CHUNK), 0.1),
        "vnorm_gmlp": 1.0 + nrm(ks[9], (DEPTH, GMLP_WIDTH), 0.02),
        "w_pool": nrm(ks[10], (DEPTH, POOL_GROUPS, POOL_GROUP_DIM, POOL_GROUP_DIM), POOL_GROUP_DIM ** -0.5),
        "b_pool": nrm(ks[11], (DEPTH, POOL_GROUPS, POOL_GROUP_DIM), 0.01),
        "pool_scale": 1.0 + nrm(ks[12], (DEPTH, POOL_WIDTH), 0.1),
        "w_branch": nrm(ks[13], (DEPTH, N_BRANCH, BRANCH_WIDTH, D_MODEL), BRANCH_WIDTH ** -0.5),
        "w_out": nrm(ks[14], (DEPTH, D_MODEL, D_MODEL), D_MODEL ** -0.5),
        "w_ff1": nrm(ks[15], (DEPTH, D_MODEL, D_FF), D_MODEL ** -0.5),
        "w_ff2": nrm(ks[16], (DEPTH, D_FF, D_MODEL), D_FF ** -0.5),
        "final_norm": 1.0 + nrm(ks[17], (D_MODEL,), 0.02),
    }


def reference(x, c, positions, w_ada, b_ada, norm1, norm2, w_in, ws_gmlp, bs_gmlp, vnorm_gmlp,
              w_pool, b_pool, pool_scale, w_branch, w_out, w_ff1, w_ff2, final_norm):
    B, S, _ = x.shape
    c_act = jax.nn.silu(c)
    for l in range(DEPTH):
        mod = c_act @ w_ada[l] + b_ada[l]
        sh1, sc1, gt1, sh2, sc2, gt2 = [m[:, None, :] for m in jnp.split(mod, N_MOD, axis=-1)]

        h = rms_norm(x, norm1[l]) * (1.0 + sc1) + sh1
        proj = h @ w_in[l]
        q, k, v, g, u, vs, p, gate_cols = split_columns(proj)
        y_ret = retention(q, k, v, g, positions)
        y_sgu = spatial_gating(u, vs, ws_gmlp[l], bs_gmlp[l], vnorm_gmlp[l])
        y_pool = multiscale_pool(p, w_pool[l], b_pool[l], pool_scale[l])
        branches = jnp.stack([y_ret, y_sgu, y_pool], axis=2)
        branch_proj = jnp.einsum('bsnc,ncd->bsnd', branches, w_branch[l])
        gates = jax.nn.sigmoid(gate_cols.reshape(B, S, N_BRANCH, D_MODEL))
        merged = jnp.sum(gates * branch_proj, axis=2)
        x = x + gt1 * (merged @ w_out[l])

        h2 = rms_norm(x, norm2[l]) * (1.0 + sc2) + sh2
        hidden = jnp.square(jax.nn.relu(h2 @ w_ff1[l]))
        x = x + gt2 * (hidden @ w_ff2[l])
    return rms_norm(x, final_norm)
```

```cpp
#include <hip/hip_runtime.h>
#include <hip/hip_cooperative_groups.h>
#include <cstdio>
#include <cstdint>
namespace cg = cooperative_groups;

#define LAS __attribute__((address_space(3)))
typedef unsigned short bf16_t;
typedef short bf16x8 __attribute__((ext_vector_type(8)));
typedef float f32x4 __attribute__((ext_vector_type(4)));
typedef float f32x2 __attribute__((ext_vector_type(2)));
typedef unsigned u32x4 __attribute__((ext_vector_type(4)));
typedef unsigned u32x2 __attribute__((ext_vector_type(2)));

constexpr int MTOK = 16384, DM = 1024, SEQ = 2048, NB = 8, DFF = 4096, DIN = 9216;
constexpr float EPS = 1e-6f;

constexpr size_t OFF_MOD = 4096;
constexpr size_t OFF_SUMSQ = OFF_MOD + 393216;
constexpr size_t OFF_WIN = OFF_SUMSQ + 65536;
constexpr size_t OFF_WPOOL = OFF_WIN + 18874368;
constexpr size_t OFF_WBR = OFF_WPOOL + 524288;
constexpr size_t OFF_WOUT = OFF_WBR + 6291456;
constexpr size_t OFF_WFF1 = OFF_WIN;
constexpr size_t OFF_WFF2 = OFF_WIN + 8388608;
constexpr size_t OFF_SLOTS = OFF_WOUT + 2097152;
constexpr size_t SLOT = 33554432;
constexpr size_t OFF_BAR = OFF_SLOTS + 8 * SLOT;
constexpr size_t WS_NEED = OFF_BAR + 16384;
#define SLOTP(i) (OFF_SLOTS + (size_t)(i) * SLOT)

struct Params {
    const float *x, *c; const int* pos;
    const float *w_ada, *b_ada, *norm1, *norm2, *w_in, *ws_gmlp, *bs_gmlp, *vnorm, *w_pool, *b_pool, *pool_scale, *w_branch, *w_out, *w_ff1, *w_ff2, *final_norm;
    float* out; unsigned char* ws;
    int ph_lo, ph_hi;
};

typedef __bf16 bf16x2_t __attribute__((ext_vector_type(2)));
__device__ __forceinline__ unsigned pk2(float lo, float hi) { f32x2 v = {lo, hi}; return __builtin_bit_cast(unsigned, __builtin_convertvector(v, bf16x2_t)); }
__device__ __forceinline__ float bflo(unsigned u) { return __uint_as_float(u << 16); }
__device__ __forceinline__ float bfhi(unsigned u) { return __uint_as_float(u & 0xffff0000u); }
__device__ __forceinline__ float wave_sum(float v) {
#pragma unroll
    for (int o = 1; o < 64; o <<= 1) v += __shfl_xor(v, o);
    return v;
}
__device__ __forceinline__ float sigmoidf_(float x) { return __builtin_amdgcn_rcpf(1.0f + __expf(-x)); }
__device__ __forceinline__ float siluf_(float x) { return x * sigmoidf_(x); }
__device__ __forceinline__ float gelu_tanh(float x) { const float u = 1.5957691216057308f * (x + 0.044715f * x * x * x); return x * sigmoidf_(u); }
#define LDS_WAIT() asm volatile("s_waitcnt lgkmcnt(0)" ::: "memory")

namespace pg8 {
constexpr int BM = 256, BK = 64, HALF = 128, HTB = HALF * BK * 2, STAGE_BYTES = 8 * HTB, NXCD = 8, WGM = 8;
__host__ __device__ __forceinline__ int lds_byte(int r, int c) { const int st = (r >> 4) * 2 + (c >> 5), rr = r & 15, cc = c & 31, ob = rr * 64 + cc * 2; return st * 1024 + (ob ^ (((ob >> 9) & 1) << 5)); }
__host__ __device__ __forceinline__ void stage_rc(int b, int& R, int& C) { const int st = b / 1024, sb = b % 1024, swz = sb ^ (((sb >> 9) & 1) << 5); R = (st >> 1) * 16 + swz / 64; C = (st & 1) * 32 + (swz % 64) / 2; }
__host__ __device__ __forceinline__ int perm32(int rho) { const int n = rho >> 4, i = rho & 15; return 8 * (i >> 2) + 4 * n + (i & 3); }

struct Unit { int pm, pn, z; const char* a; const char* b; };
struct Gemm { int lda, ldb, K; };

struct StaticOrder {
    int nM, nN, nwg, G, c;
    __device__ __forceinline__ void init(int nM_, int nN_, int G_, int c_) { nM = nM_; nN = nN_; nwg = nM * nN; G = G_; c = c_; }
    __device__ __forceinline__ bool map(int i, int& pm, int& pn) const {
        const long L = (long)i * G + c; if (L >= nwg) return false;
        int wgid = (int)L; { const int q = nwg / NXCD, r = nwg % NXCD, xcd = wgid % NXCD, off = wgid / NXCD; wgid = (xcd < r ? xcd * (q + 1) : r * (q + 1) + (xcd - r) * q) + off; }
        const int nig = WGM * nN, gid = wgid / nig, fm = gid * WGM, gsz = (nM - fm) < WGM ? (nM - fm) : WGM;
        pm = fm + ((wgid % nig) % gsz); pn = (wgid % nig) / gsz; return true;
    }
};
struct PlainSched {
    StaticOrder so; const char* A; const char* B; size_t tA, tB;
    __device__ __forceinline__ bool next(int i, Unit& u) const { if (!so.map(i, u.pm, u.pn)) return false; u.z = 0; u.a = A + (size_t)u.pm * tA; u.b = B + (size_t)u.pn * tB; return true; }
    __device__ __forceinline__ void a_ready(const Unit&) const {}
    __device__ __forceinline__ void done(const Unit&) const {}
};

template <class Epi, class Sched>
__device__ __forceinline__ void gemm_phase(LAS unsigned char* lds, const Gemm g, const Sched& S, const Epi& E) {
    int tidq = threadIdx.x; asm volatile("" : "+v"(tidq));
    const int tid = tidq, wid = __builtin_amdgcn_readfirstlane(tid >> 6), lane = tid & 63, wr = wid >> 2, wc = wid & 3, fr = lane & 15, fq = lane >> 4;
    int Kq = g.K; asm volatile("" : "+s"(Kq));
    const int K = Kq, nt = K / BK;
    unsigned voffA[2], voffB[2];
#pragma unroll
    for (int i = 0; i < 2; ++i) { int R, C; stage_rc(tid * 16 + i * 8192, R, C); const int Rb = Epi::PERM ? ((R & ~31) + perm32(R & 31)) : R;
        voffA[i] = (unsigned)(R * g.lda + C) * 2u; voffB[i] = (unsigned)(Rb * g.ldb + C) * 2u; }
    const size_t kstep = (size_t)(BK * 2);
    const size_t hstepA = (size_t)HALF * g.lda * 2, hstepB = (size_t)HALF * g.ldb * 2;
    const unsigned ldsw = (unsigned)wid * 1024u;
    const int aoff = lds_byte(wr * 64 + fr, fq * 8), boff = lds_byte(wc * 32 + fr, fq * 8);
#define PG8_SA(b, h) (((b) * 2 + (h)) * HTB)
#define PG8_SB(b, h) ((4 + (b) * 2 + (h)) * HTB)
#define PG8_STAGE(bufoff, gbase, voff) do { _Pragma("unroll") for (int _i = 0; _i < 2; ++_i) \
        __builtin_amdgcn_global_load_lds((const unsigned*)((const char*)(gbase) + (voff)[_i]), (LAS unsigned*)(lds + (bufoff) + ldsw + _i * 8192), 16, 0, 0); } while (0)
#define PG8_LDA(dst, b, h) do { _Pragma("unroll") for (int m = 0; m < 4; ++m) _Pragma("unroll") for (int k = 0; k < 2; ++k) dst[m][k] = *(const LAS bf16x8*)(lds + PG8_SA(b, h) + aoff + m * 2048 + k * 1024); } while (0)
#define PG8_LDB(dst, b, h) do { _Pragma("unroll") for (int n = 0; n < 2; ++n) _Pragma("unroll") for (int k = 0; k < 2; ++k) dst[n][k] = *(const LAS bf16x8*)(lds + PG8_SB(b, h) + boff + n * 2048 + k * 1024); } while (0)
#define PG8_MMA(ai, bj, At, Bt) do { __builtin_amdgcn_s_setprio(1); _Pragma("unroll") for (int m = 0; m < 4; ++m) _Pragma("unroll") for (int n = 0; n < 2; ++n) _Pragma("unroll") for (int k = 0; k < 2; ++k) \
        acc[ai][bj][m][n] = __builtin_amdgcn_mfma_f32_16x16x32_bf16(Bt[n][k], At[m][k], acc[ai][bj][m][n], 0, 0, 0); __builtin_amdgcn_s_setprio(0); } while (0)
#define PG8_WAIT_V(n) asm volatile("s_waitcnt vmcnt(" #n ")" ::: "memory")
#define PG8_WAIT_L(n) asm volatile("s_waitcnt lgkmcnt(" #n ")" ::: "memory")
#define PG8_BAR __builtin_amdgcn_s_barrier()
#define PG8_SCHED __builtin_amdgcn_sched_barrier(0)
    Unit cur, nxt; int ui = 0;
    if (!S.next(0, cur)) return;
    f32x4 acc[2][2][4][2];
#pragma unroll
    for (int a = 0; a < 2; ++a)
#pragma unroll
        for (int b = 0; b < 2; ++b)
#pragma unroll
            for (int m = 0; m < 4; ++m)
#pragma unroll
                for (int n = 0; n < 2; ++n) acc[a][b][m][n] = (f32x4){0.f, 0.f, 0.f, 0.f};
    bf16x8 At[4][2], B0[2][2], B1[2][2];
    const char* cA = cur.a; const char* cB = cur.b;
    S.a_ready(cur);
    PG8_STAGE(PG8_SB(0, 0), cB, voffB); PG8_STAGE(PG8_SB(0, 1), cB + hstepB, voffB); PG8_STAGE(PG8_SA(0, 0), cA, voffA); PG8_STAGE(PG8_SA(0, 1), cA + hstepA, voffA);
    if (wr == 1) PG8_BAR;
    PG8_WAIT_V(2); PG8_BAR;
    PG8_STAGE(PG8_SB(1, 0), cB + kstep, voffB); PG8_STAGE(PG8_SA(1, 0), cA + kstep, voffA); PG8_STAGE(PG8_SB(1, 1), cB + hstepB + kstep, voffB);
    PG8_WAIT_V(6); PG8_BAR;
    for (;;) {
        const bool has_next = S.next(ui + 1, nxt);
        const char* nA = has_next ? nxt.a : cA; const char* nB = has_next ? nxt.b : cB;
        for (int t = 0; t < nt; t += 2) {
            const bool last = (t == nt - 2);
            const char* a1 = cA + (size_t)(t + 1) * kstep;
            const char* a2 = last ? nA : cA + (size_t)(t + 2) * kstep; const char* b2 = last ? nB : cB + (size_t)(t + 2) * kstep;
            const char* a3 = a2 + kstep; const char* b3 = b2 + kstep;
            if (last && has_next) S.a_ready(nxt);
            PG8_LDB(B0, 0, 0); PG8_LDB(B1, 0, 1); PG8_SCHED; PG8_LDA(At, 0, 0); PG8_STAGE(PG8_SA(1, 1), a1 + hstepA, voffA);
            PG8_WAIT_V(8); PG8_WAIT_L(0); PG8_BAR; PG8_MMA(0, 0, At, B0); PG8_MMA(0, 1, At, B1); PG8_BAR; PG8_SCHED;
            PG8_LDA(At, 0, 1); PG8_STAGE(PG8_SB(0, 0), b2, voffB); PG8_STAGE(PG8_SB(0, 1), b2 + hstepB, voffB); PG8_STAGE(PG8_SA(0, 0), a2, voffA);
            PG8_WAIT_V(8); PG8_WAIT_L(0); PG8_BAR; PG8_MMA(1, 0, At, B0); PG8_MMA(1, 1, At, B1); PG8_BAR; PG8_SCHED;
            PG8_LDB(B0, 1, 0); PG8_LDB(B1, 1, 1); PG8_SCHED; PG8_LDA(At, 1, 0); PG8_STAGE(PG8_SA(0, 1), a2 + hstepA, voffA);
            PG8_WAIT_V(8); PG8_WAIT_L(0); PG8_BAR; PG8_MMA(0, 0, At, B0); PG8_MMA(0, 1, At, B1); PG8_BAR; PG8_SCHED;
            PG8_LDA(At, 1, 1); PG8_STAGE(PG8_SB(1, 0), b3, voffB); PG8_STAGE(PG8_SB(1, 1), b3 + hstepB, voffB); PG8_STAGE(PG8_SA(1, 0), a3, voffA);
            PG8_WAIT_V(8); PG8_WAIT_L(0); PG8_BAR; PG8_MMA(1, 0, At, B0); PG8_MMA(1, 1, At, B1); PG8_BAR; PG8_SCHED;
        }
        if (wr == 0) PG8_BAR;
        E(acc, cur, wr, wc, fr, fq); S.done(cur);
        if (!has_next) break;
#pragma unroll
        for (int a = 0; a < 2; ++a)
#pragma unroll
            for (int b = 0; b < 2; ++b)
#pragma unroll
                for (int m = 0; m < 4; ++m)
#pragma unroll
                    for (int n = 0; n < 2; ++n) acc[a][b][m][n] = (f32x4){0.f, 0.f, 0.f, 0.f};
        cur = nxt; cA = nA; cB = nB; ++ui;
        if (wr == 1) PG8_BAR;
    }
    PG8_WAIT_V(0);
    PG8_BAR;
#undef PG8_SA
#undef PG8_SB
#undef PG8_STAGE
#undef PG8_LDA
#undef PG8_LDB
#undef PG8_MMA
#undef PG8_WAIT_V
#undef PG8_WAIT_L
#undef PG8_BAR
#undef PG8_SCHED
}
}
using pg8::Unit;
typedef const f32x4 (&AccRef)[2][2][4][2];

struct EpiIn {
    static constexpr bool PERM = true;
    unsigned char* slots;
    __device__ __forceinline__ void operator()(AccRef acc, const Unit& u, int wr, int wc, int fr, int fq) const {
        const int seg = u.pn >> 2;
        bf16_t* base = (bf16_t*)(slots + (size_t)(seg + 1 + (seg == 3 ? 1 : 0)) * SLOT);
        const int row0 = u.pm * 256 + wr * 64 + fr, col0 = (u.pn & 3) * 256 + wc * 32 + 8 * fq;
#pragma unroll
        for (int ai = 0; ai < 2; ++ai)
#pragma unroll
            for (int m = 0; m < 4; ++m) { bf16_t* rowp = base + (size_t)(row0 + ai * 128 + m * 16) * 1024 + col0;
#pragma unroll
                for (int bj = 0; bj < 2; ++bj) { f32x4 v0 = acc[ai][bj][m][0], v1 = acc[ai][bj][m][1];
                    u32x4 w; w.x = pk2(v0[0], v0[1]); w.y = pk2(v0[2], v0[3]); w.z = pk2(v1[0], v1[1]); w.w = pk2(v1[2], v1[3]);
                    *(u32x4*)(rowp + bj * 128) = w; } }
    }
};
struct EpiInT {
    static constexpr bool PERM = true;
    bf16_t *vT, *vsT; float* sumsq;
    __device__ __forceinline__ void operator()(AccRef acc, const Unit& u, int wr, int wc, int fr, int fq) const {
        const bool isvs = u.pm >= 4;
        bf16_t* base = isvs ? vsT : vT;
        const int cs0 = (u.pm & 3) * 256 + wr * 64 + fr;
        const int j0 = wc * 32 + 8 * fq;
        float ss[2][8];
#pragma unroll
        for (int bj = 0; bj < 2; ++bj)
#pragma unroll
            for (int k = 0; k < 8; ++k) ss[bj][k] = 0.f;
#pragma unroll
        for (int ai = 0; ai < 2; ++ai)
#pragma unroll
            for (int m = 0; m < 4; ++m) { const int cs = cs0 + ai * 128 + m * 16;
#pragma unroll
                for (int bj = 0; bj < 2; ++bj) { f32x4 v0 = acc[ai][bj][m][0], v1 = acc[ai][bj][m][1];
                    if (isvs) {
#pragma unroll
                        for (int j = 0; j < 4; ++j) { v0[j] = gelu_tanh(v0[j]); v1[j] = gelu_tanh(v1[j]); ss[bj][j] += v0[j] * v0[j]; ss[bj][4 + j] += v1[j] * v1[j]; } }
                    u32x4 w; w.x = pk2(v0[0], v0[1]); w.y = pk2(v0[2], v0[3]); w.z = pk2(v1[0], v1[1]); w.w = pk2(v1[2], v1[3]);
                    const int bn = 2 * u.pn + bj;
                    *(u32x4*)(base + ((size_t)bn * 1024 + cs) * 128 + j0) = w; } }
        if (isvs) {
#pragma unroll
            for (int bj = 0; bj < 2; ++bj)
#pragma unroll
                for (int k = 0; k < 8; ++k) { float s = ss[bj][k]; s += __shfl_xor(s, 1); s += __shfl_xor(s, 2); s += __shfl_xor(s, 4); s += __shfl_xor(s, 8);
                    if (fr == 0) atomicAdd(sumsq + u.pn * 256 + bj * 128 + j0 + k, s); }
        }
    }
};
struct EpiPool {
    static constexpr bool PERM = true;
    bf16_t* y; const float* bias; const float* scale;
    __device__ __forceinline__ void operator()(AccRef acc, const Unit& u, int wr, int wc, int fr, int fq) const {
        const int row0 = u.pm * 256 + wr * 64 + fr, col0 = u.z * 256 + wc * 32 + 8 * fq;
#pragma unroll
        for (int bj = 0; bj < 2; ++bj) {
            const f32x4 b0 = *(const f32x4*)(bias + col0 + bj * 128), b1 = *(const f32x4*)(bias + col0 + bj * 128 + 4), s0 = *(const f32x4*)(scale + col0 + bj * 128), s1 = *(const f32x4*)(scale + col0 + bj * 128 + 4);
#pragma unroll
            for (int ai = 0; ai < 2; ++ai)
#pragma unroll
                for (int m = 0; m < 4; ++m) { bf16_t* rowp = y + (size_t)(row0 + ai * 128 + m * 16) * 1024 + col0;
                    const f32x4 v0 = (acc[ai][bj][m][0] + b0) * s0, v1 = (acc[ai][bj][m][1] + b1) * s1;
                    u32x4 w; w.x = pk2(v0[0], v0[1]); w.y = pk2(v0[2], v0[3]); w.z = pk2(v1[0], v1[1]); w.w = pk2(v1[2], v1[3]);
                    *(u32x4*)(rowp + bj * 128) = w; } }
    }
};
struct EpiBranch {
    static constexpr bool PERM = true;
    bf16_t* gcur; bf16_t* tmp; bf16_t* merged;
    __device__ __forceinline__ void operator()(AccRef acc, const Unit& u, int wr, int wc, int fr, int fq) const {
        const int row0 = u.pm * 256 + wr * 64 + fr, col0 = u.pn * 256 + wc * 32 + 8 * fq;
        const int z = u.z;
        if ((z & 1) == 0) {
#pragma unroll
            for (int ai = 0; ai < 2; ++ai)
#pragma unroll
                for (int m = 0; m < 4; ++m)
#pragma unroll
                    for (int bj = 0; bj < 2; ++bj) { f32x4 v0 = acc[ai][bj][m][0], v1 = acc[ai][bj][m][1];
                        const size_t o = (size_t)(row0 + ai * 128 + m * 16) * 1024 + col0 + bj * 128;
#pragma unroll
                        for (int j = 0; j < 4; ++j) { v0[j] = sigmoidf_(v0[j]); v1[j] = sigmoidf_(v1[j]); }
                        u32x4 w; w.x = pk2(v0[0], v0[1]); w.y = pk2(v0[2], v0[3]); w.z = pk2(v1[0], v1[1]); w.w = pk2(v1[2], v1[3]);
                        *(u32x4*)(gcur + o) = w; }
        } else {
            bf16_t* dst = (z == 5) ? merged : tmp;
#pragma unroll
            for (int ai = 0; ai < 2; ++ai) {
                u32x4 gw[4][2], tw[4][2];
#pragma unroll
                for (int m = 0; m < 4; ++m)
#pragma unroll
                    for (int bj = 0; bj < 2; ++bj) { const size_t o = (size_t)(row0 + ai * 128 + m * 16) * 1024 + col0 + bj * 128;
                        gw[m][bj] = *(const u32x4*)(gcur + o);
                        tw[m][bj] = (z != 1) ? *(const u32x4*)(tmp + o) : (u32x4){0u, 0u, 0u, 0u}; }
                asm volatile("" ::: "memory");
#pragma unroll
                for (int m = 0; m < 4; ++m)
#pragma unroll
                    for (int bj = 0; bj < 2; ++bj) { const size_t o = (size_t)(row0 + ai * 128 + m * 16) * 1024 + col0 + bj * 128;
                        const u32x4 g = gw[m][bj], t = tw[m][bj];
                        const f32x4 g0 = {bflo(g.x), bfhi(g.x), bflo(g.y), bfhi(g.y)}, g1 = {bflo(g.z), bfhi(g.z), bflo(g.w), bfhi(g.w)};
                        const f32x4 t0 = {bflo(t.x), bfhi(t.x), bflo(t.y), bfhi(t.y)}, t1 = {bflo(t.z), bfhi(t.z), bflo(t.w), bfhi(t.w)};
                        const f32x4 v0 = acc[ai][bj][m][0] * g0 + t0, v1 = acc[ai][bj][m][1] * g1 + t1;
                        u32x4 w; w.x = pk2(v0[0], v0[1]); w.y = pk2(v0[2], v0[3]); w.z = pk2(v1[0], v1[1]); w.w = pk2(v1[2], v1[3]);
                        *(u32x4*)(dst + o) = w; }
                asm volatile("" ::: "memory");
            }
        }
    }
};
struct EpiResid {
    static constexpr bool PERM = false;
    const float* xsrc; float* xdst; const float* gate;
    __device__ __forceinline__ void operator()(AccRef acc, const Unit& u, int wr, int wc, int fr, int fq) const {
        const int row0 = u.pm * 256 + wr * 64 + fr, col0 = u.pn * 256 + wc * 32 + 4 * fq;
        const float* gp = gate + (size_t)(u.pm >> 3) * 6144 + col0;
        f32x4 gv[2][2];
#pragma unroll
        for (int bj = 0; bj < 2; ++bj)
#pragma unroll
            for (int n = 0; n < 2; ++n) gv[bj][n] = *(const f32x4*)(gp + bj * 128 + n * 16);
#pragma unroll
        for (int ab = 0; ab < 4; ++ab) { const int ai = ab >> 1, m0 = (ab & 1) * 2;
            f32x4 xv[2][2][2];
#pragma unroll
            for (int mm = 0; mm < 2; ++mm)
#pragma unroll
                for (int bj = 0; bj < 2; ++bj)
#pragma unroll
                    for (int n = 0; n < 2; ++n) xv[mm][bj][n] = *(const f32x4*)(xsrc + (size_t)(row0 + ai * 128 + (m0 + mm) * 16) * 1024 + col0 + bj * 128 + n * 16);
            asm volatile("" ::: "memory");
#pragma unroll
            for (int mm = 0; mm < 2; ++mm)
#pragma unroll
                for (int bj = 0; bj < 2; ++bj)
#pragma unroll
                    for (int n = 0; n < 2; ++n) *(f32x4*)(xdst + (size_t)(row0 + ai * 128 + (m0 + mm) * 16) * 1024 + col0 + bj * 128 + n * 16) = xv[mm][bj][n] + gv[bj][n] * acc[ai][bj][m0 + mm][n];
            asm volatile("" ::: "memory");
        }
    }
};
struct EpiResidB {
    static constexpr bool PERM = true;
    const float* xf; const bf16_t* xb; bf16_t* xdst; const float* gate; int src_f32;
    __device__ __forceinline__ void operator()(AccRef acc, const Unit& u, int wr, int wc, int fr, int fq) const {
        const int row0 = u.pm * 256 + wr * 64 + fr, col0 = u.pn * 256 + wc * 32 + 8 * fq;
        const float* gp = gate + (size_t)(u.pm >> 3) * 6144 + col0;
        f32x4 gv[2][2];
#pragma unroll
        for (int bj = 0; bj < 2; ++bj)
#pragma unroll
            for (int n = 0; n < 2; ++n) gv[bj][n] = *(const f32x4*)(gp + bj * 128 + 4 * n);
#pragma unroll
        for (int ab = 0; ab < 4; ++ab) { const int ai = ab >> 1, m0 = (ab & 1) * 2;
            f32x4 x0[2][2], x1[2][2];
            if (src_f32) {
#pragma unroll
                for (int mm = 0; mm < 2; ++mm)
#pragma unroll
                    for (int bj = 0; bj < 2; ++bj) { const float* sp = xf + (size_t)(row0 + ai * 128 + (m0 + mm) * 16) * 1024 + col0 + bj * 128;
                        x0[mm][bj] = __builtin_nontemporal_load((const f32x4*)sp); x1[mm][bj] = __builtin_nontemporal_load((const f32x4*)(sp + 4)); }
            } else {
                u32x4 w[2][2];
#pragma unroll
                for (int mm = 0; mm < 2; ++mm)
#pragma unroll
                    for (int bj = 0; bj < 2; ++bj) w[mm][bj] = *(const u32x4*)(xb + (size_t)(row0 + ai * 128 + (m0 + mm) * 16) * 1024 + col0 + bj * 128);
#pragma unroll
                for (int mm = 0; mm < 2; ++mm)
#pragma unroll
                    for (int bj = 0; bj < 2; ++bj) { const u32x4 t = w[mm][bj];
                        x0[mm][bj] = (f32x4){bflo(t.x), bfhi(t.x), bflo(t.y), bfhi(t.y)}; x1[mm][bj] = (f32x4){bflo(t.z), bfhi(t.z), bflo(t.w), bfhi(t.w)}; }
            }
            asm volatile("" ::: "memory");
#pragma unroll
            for (int mm = 0; mm < 2; ++mm)
#pragma unroll
                for (int bj = 0; bj < 2; ++bj) { const f32x4 v0 = x0[mm][bj] + gv[bj][0] * acc[ai][bj][m0 + mm][0], v1 = x1[mm][bj] + gv[bj][1] * acc[ai][bj][m0 + mm][1];
                    u32x4 o; o.x = pk2(v0[0], v0[1]); o.y = pk2(v0[2], v0[3]); o.z = pk2(v1[0], v1[1]); o.w = pk2(v1[2], v1[3]);
                    *(u32x4*)(xdst + (size_t)(row0 + ai * 128 + (m0 + mm) * 16) * 1024 + col0 + bj * 128) = o; }
            asm volatile("" ::: "memory");
        }
    }
};
struct EpiFF1 {
    static constexpr bool PERM = true;
    bf16_t* hid;
    __device__ __forceinline__ void operator()(AccRef acc, const Unit& u, int wr, int wc, int fr, int fq) const {
        const int row0 = u.pm * 256 + wr * 64 + fr, col0 = u.pn * 256 + wc * 32 + 8 * fq;
#pragma unroll
        for (int ai = 0; ai < 2; ++ai)
#pragma unroll
            for (int m = 0; m < 4; ++m) { bf16_t* rowp = hid + (size_t)(row0 + ai * 128 + m * 16) * 4096 + col0;
#pragma unroll
                for (int bj = 0; bj < 2; ++bj) { f32x4 v0 = acc[ai][bj][m][0], v1 = acc[ai][bj][m][1];
#pragma unroll
                    for (int j = 0; j < 4; ++j) { const float a = fmaxf(v0[j], 0.f), b = fmaxf(v1[j], 0.f); v0[j] = a * a; v1[j] = b * b; }
                    u32x4 w; w.x = pk2(v0[0], v0[1]); w.y = pk2(v0[2], v0[3]); w.z = pk2(v1[0], v1[1]); w.w = pk2(v1[2], v1[3]);
                    *(u32x4*)(rowp + bj * 128) = w; } }
    }
};
struct BranchSched {
    pg8::StaticOrder so; const char *h, *wg, *slots, *wb;
    __device__ __forceinline__ bool next(int i, Unit& u) const {
        const int ti = i / 6, sub = i - ti * 6;
        if (!so.map(ti, u.pm, u.pn)) return false;
        u.z = sub; const int n = sub >> 1;
        if ((sub & 1) == 0) { u.a = h + (size_t)u.pm * (256 * 1024 * 2); u.b = wg + ((size_t)n * 1024 + (size_t)u.pn * 256) * 2048; }
        else { const char* y = slots + (size_t)((2 + n) & 3) * SLOT; u.a = y + (size_t)u.pm * (256 * 1024 * 2); u.b = wb + ((size_t)n * 1024 + (size_t)u.pn * 256) * 2048; }
        return true;
    }
    __device__ __forceinline__ void a_ready(const Unit&) const {}
    __device__ __forceinline__ void done(const Unit&) const {}
};
struct PoolSched {
    int G, c; const char *pooled, *wp;
    __device__ __forceinline__ bool next(int i, Unit& u) const {
        const int L = i * G + c; if (L >= 256) return false;
        u.pm = L & 63; u.z = L >> 6; u.pn = 0;
        u.a = pooled + (size_t)u.pm * (256 * 1024 * 2) + (size_t)u.z * 512; u.b = wp + (size_t)u.z * (256 * 256 * 2);
        return true;
    }
    __device__ __forceinline__ void a_ready(const Unit&) const {}
    __device__ __forceinline__ void done(const Unit&) const {}
};

__device__ __forceinline__ int winmap(int n0) {
    if (n0 < 1024) return n0;
    if (n0 < 2048) return 4096 + (n0 - 1024);
    if (n0 < 4096) return 1024 + (n0 - 2048);
    if (n0 < 5120) return 5120 + (n0 - 4096);
    if (n0 < 6144) return 3072 + (n0 - 5120);
    return n0;
}
template <bool WINMAP>
__device__ __forceinline__ void conv_item(const float* W, int K, int N, bf16_t* WT, int item, float* scr, int lane) {
    const int nblk = N / 32, kb = item / nblk, nb = item - kb * nblk, k0 = 64 * kb, n0 = 32 * nb;
    const int r0 = WINMAP ? winmap(n0) : n0;
#pragma unroll 8
    for (int i = 0; i < 32; ++i) { const int kk = 2 * i + (lane >> 5); scr[kk * 33 + (lane & 31)] = __builtin_nontemporal_load(&W[(size_t)(k0 + kk) * N + n0 + (lane & 31)]); }
    LDS_WAIT();
    const int c = lane & 7;
#pragma unroll
    for (int j = 0; j < 4; ++j) { const int n = (lane >> 3) + 8 * j; const float* s = scr + (8 * c) * 33 + n;
        u32x4 o; o.x = pk2(s[0 * 33], s[1 * 33]); o.y = pk2(s[2 * 33], s[3 * 33]); o.z = pk2(s[4 * 33], s[5 * 33]); o.w = pk2(s[6 * 33], s[7 * 33]);
        *(u32x4*)(WT + (size_t)(r0 + n) * K + k0 + 8 * c) = o; }
    LDS_WAIT();
}
template <bool WINMAP>
__device__ __forceinline__ void conv_quarter(const float* W, int K, int N, bf16_t* WT, int item, int q, float* scr, int lane) {
    const int nblk = N / 32, kb = item / nblk, nb = item - kb * nblk, k0 = 64 * kb + 16 * q, n0 = 32 * nb;
    const int r0 = WINMAP ? winmap(n0) : n0;
#pragma unroll
    for (int i = 0; i < 8; ++i) { const int kk = 2 * i + (lane >> 5); scr[kk * 33 + (lane & 31)] = __builtin_nontemporal_load(&W[(size_t)(k0 + kk) * N + n0 + (lane & 31)]); }
    LDS_WAIT();
    { const int c = lane & 1, n = lane >> 1; const float* sp = scr + (8 * c) * 33 + n;
      u32x4 o; o.x = pk2(sp[0 * 33], sp[1 * 33]); o.y = pk2(sp[2 * 33], sp[3 * 33]); o.z = pk2(sp[4 * 33], sp[5 * 33]); o.w = pk2(sp[6 * 33], sp[7 * 33]);
      *(u32x4*)(WT + (size_t)(r0 + n) * K + k0 + 8 * c) = o; }
    LDS_WAIT();
}
__device__ __forceinline__ void conv_set(const Params& p, int l, int set, unsigned char* lds, int gw, int ngw, int wave, int lane) {
    float* scr = (float*)(lds + wave * 8704);
    if (set == 0) {
        const int nfull = (4608 / ngw) * ngw, nrem = 4608 - nfull;
        for (int it = gw; it < nfull; it += ngw) conv_item<true>(p.w_in + (size_t)l * DM * DIN, 1024, DIN, (bf16_t*)(p.ws + OFF_WIN), it, scr, lane);
        for (int qi = gw; qi < nrem * 4; qi += ngw) conv_quarter<true>(p.w_in + (size_t)l * DM * DIN, 1024, DIN, (bf16_t*)(p.ws + OFF_WIN), nfull + (qi >> 2), qi & 3, scr, lane);
        for (int r = gw; r < 128; r += ngw) { const int g = r >> 5; conv_item<false>(p.w_pool + ((size_t)l * 4 + g) * 65536, 256, 256, (bf16_t*)(p.ws + OFF_WPOOL) + (size_t)g * 65536, r & 31, scr, lane); }
    } else if (set == 1) {
        for (int it = gw; it < 2048; it += ngw) {
            if (it < 1536) { const int n = it >> 9; conv_item<false>(p.w_branch + ((size_t)l * 3 + n) * 1048576, 1024, 1024, (bf16_t*)(p.ws + OFF_WBR) + (size_t)n * 1048576, it & 511, scr, lane); }
            else conv_item<false>(p.w_out + (size_t)l * 1048576, 1024, 1024, (bf16_t*)(p.ws + OFF_WOUT), it - 1536, scr, lane);
        }
    } else {
        for (int it = gw; it < 4096; it += ngw) {
            if (it < 2048) conv_item<false>(p.w_ff1 + (size_t)l * 4194304, 1024, 4096, (bf16_t*)(p.ws + OFF_WFF1), it, scr, lane);
            else conv_item<false>(p.w_ff2 + (size_t)l * 4194304, 4096, 1024, (bf16_t*)(p.ws + OFF_WFF2), it - 2048, scr, lane);
        }
    }
}

__device__ __forceinline__ void norm_rows(const float* xsrc, bf16_t* hdst, const float* gain, const float* modl  , int gw, int ngw, int lane) {
    for (int row = gw; row < MTOK; row += ngw) {
        const int b = row >> 11;
        const f32x4* xr = (const f32x4*)(xsrc + (size_t)row * 1024) + lane;
        f32x4 v[4]; float s = 0.f;
#pragma unroll
        for (int j = 0; j < 4; ++j) { v[j] = xr[64 * j]; s += (v[j].x * v[j].x + v[j].y * v[j].y) + (v[j].z * v[j].z + v[j].w * v[j].w); }
        const float rstd = rsqrtf(wave_sum(s) * (1.f / 1024.f) + EPS);
        const float* sh = modl + (size_t)b * 6144; const float* sc = sh + 1024;
        u32x2* o8 = (u32x2*)(hdst + (size_t)row * 1024) + lane;
        f32x4 ga[4], ca[4], ha[4];
#pragma unroll
        for (int j = 0; j < 4; ++j) { const int col = (lane + 64 * j) * 4; ga[j] = *(const f32x4*)(gain + col); ca[j] = *(const f32x4*)(sc + col); ha[j] = *(const f32x4*)(sh + col); }
#pragma unroll
        for (int j = 0; j < 4; ++j) {
            const f32x4 g = ga[j], c4 = ca[j], h4 = ha[j];
            const f32x4 y = v[j] * rstd * g * (c4 + 1.0f) + h4;
            u32x2 w; w.x = pk2(y.x, y.y); w.y = pk2(y.z, y.w); o8[64 * j] = w; }
    }
}

__device__ __forceinline__ void norm_rows_b(const bf16_t* xsrc, bf16_t* hdst, const float* gain, const float* modl, int gw, int ngw, int lane) {
    for (int row = gw; row < MTOK; row += ngw) {
        const int b = row >> 11;
        const u32x4* xr = (const u32x4*)(xsrc + (size_t)row * 1024) + lane;
        float v[2][8]; float s = 0.f;
#pragma unroll
        for (int j = 0; j < 2; ++j) { const u32x4 t = xr[64 * j];
            v[j][0] = bflo(t.x); v[j][1] = bfhi(t.x); v[j][2] = bflo(t.y); v[j][3] = bfhi(t.y); v[j][4] = bflo(t.z); v[j][5] = bfhi(t.z); v[j][6] = bflo(t.w); v[j][7] = bfhi(t.w);
#pragma unroll
            for (int k = 0; k < 8; ++k) s += v[j][k] * v[j][k]; }
        const float rstd = rsqrtf(wave_sum(s) * (1.f / 1024.f) + EPS);
        const float* sh = modl + (size_t)b * 6144; const float* sc = sh + 1024;
        u32x4* o16 = (u32x4*)(hdst + (size_t)row * 1024) + lane;
        f32x4 ga[2][2], ca[2][2], ha[2][2];
#pragma unroll
        for (int j = 0; j < 2; ++j)
#pragma unroll
            for (int q = 0; q < 2; ++q) { const int col = (lane + 64 * j) * 8 + 4 * q; ga[j][q] = *(const f32x4*)(gain + col); ca[j][q] = *(const f32x4*)(sc + col); ha[j][q] = *(const f32x4*)(sh + col); }
#pragma unroll
        for (int j = 0; j < 2; ++j) {
            const f32x4 y0 = (f32x4){v[j][0], v[j][1], v[j][2], v[j][3]} * rstd * ga[j][0] * (ca[j][0] + 1.0f) + ha[j][0];
            const f32x4 y1 = (f32x4){v[j][4], v[j][5], v[j][6], v[j][7]} * rstd * ga[j][1] * (ca[j][1] + 1.0f) + ha[j][1];
            u32x4 w; w.x = pk2(y0.x, y0.y); w.y = pk2(y0.z, y0.w); w.z = pk2(y1.x, y1.y); w.w = pk2(y1.z, y1.w); o16[64 * j] = w; }
    }
}

#define KVBASE(p) ((bf16_t*)(p).out + (size_t)MTOK * DM)
constexpr int LROW = 272;
__device__ __forceinline__ bf16x8 asbf(u32x4 v) { return __builtin_bit_cast(bf16x8, v); }
__device__ __forceinline__ f32x4 mfma16(bf16x8 a, bf16x8 b, f32x4 c) { return __builtin_amdgcn_mfma_f32_16x16x32_bf16(a, b, c, 0, 0, 0); }
__device__ __forceinline__ void stage_rows128(unsigned char* dst, const bf16_t* src, int nrows, int tid) {
    (void)nrows;
#pragma unroll
    for (int hb = 0; hb < 2; ++hb) {
        u32x4 v[4];
#pragma unroll
        for (int i = 0; i < 4; ++i) { const int ci = tid + (hb * 4 + i) * 512; v[i] = *(const u32x4*)(src + (size_t)(ci >> 4) * 128 + (ci & 15) * 8); }
#pragma unroll
        for (int i = 0; i < 4; ++i) { const int ci = tid + (hb * 4 + i) * 512; *(u32x4*)(dst + (ci >> 4) * LROW + (ci & 15) * 16) = v[i]; }
    }
}
__device__ __forceinline__ float inv_freq(int f) { return exp2f(-(float)f * (13.287712379549449f / 64.0f)); }
__device__ __forceinline__ void rot8(u32x4 lo, u32x4 hi, float pos, int f0, float scale, u32x4& olo, u32x4& ohi) {
    float a[8], b[8];
    a[0] = bflo(lo.x); a[1] = bfhi(lo.x); a[2] = bflo(lo.y); a[3] = bfhi(lo.y); a[4] = bflo(lo.z); a[5] = bfhi(lo.z); a[6] = bflo(lo.w); a[7] = bfhi(lo.w);
    b[0] = bflo(hi.x); b[1] = bfhi(hi.x); b[2] = bflo(hi.y); b[3] = bfhi(hi.y); b[4] = bflo(hi.z); b[5] = bfhi(hi.z); b[6] = bflo(hi.w); b[7] = bfhi(hi.w);
    float o1[8], o2[8];
#pragma unroll
    for (int i = 0; i < 8; ++i) { float s, c;
#ifdef NOSINCOS
        s = 0.f; c = 1.f; (void)pos;
#else
        { const float ang = pos * inv_freq(f0 + i); s = __sinf(ang); c = __cosf(ang); }
#endif
 o1[i] = (a[i] * c - b[i] * s) * scale; o2[i] = (b[i] * c + a[i] * s) * scale; }
    olo.x = pk2(o1[0], o1[1]); olo.y = pk2(o1[2], o1[3]); olo.z = pk2(o1[4], o1[5]); olo.w = pk2(o1[6], o1[7]);
    ohi.x = pk2(o2[0], o2[1]); ohi.y = pk2(o2[2], o2[3]); ohi.z = pk2(o2[4], o2[5]); ohi.w = pk2(o2[6], o2[7]);
}
__device__ __forceinline__ float log_gamma(int h) { return log1pf(-exp2f(-5.0f - (float)h)); }

__device__ __forceinline__ void sgu_item(const Params& p, int l, int bn, int g, unsigned char* lds, int tid, int wave, int lane) {
    const int r = lane & 15, q4 = lane >> 4;
    const bf16_t* vsT = (const bf16_t*)(p.ws + SLOTP(6)) + ((size_t)bn * 1024 + g * 256) * 128;
    bf16_t* ubuf = (bf16_t*)(p.ws + SLOTP(3));
    const float* sumsq = (const float*)(p.ws + OFF_SUMSQ) + bn * 128;
    float* rs = (float*)(lds + 256 * LROW);
    __syncthreads();
    stage_rows128(lds, vsT, 256, tid);
    if (tid < 128) rs[tid] = rsqrtf(sumsq[tid] * (1.f / 1024.f) + EPS);
    __syncthreads();
    const int t = wave * 16 + r;
    const int nkk = (wave >> 1) + 1;
    const float* Wrow = p.ws_gmlp + (((size_t)l * 4 + g) * 128 + t) * 128;
    f32x4 acc[16];
#pragma unroll
    for (int i = 0; i < 16; ++i) acc[i] = (f32x4){0.f, 0.f, 0.f, 0.f};
    for (int kk = 0; kk < nkk; ++kk) {
        const int s0 = kk * 32 + q4 * 8;
        const f32x4 w0 = *(const f32x4*)(Wrow + s0), w1 = *(const f32x4*)(Wrow + s0 + 4);
        float wv[8] = {w0.x, w0.y, w0.z, w0.w, w1.x, w1.y, w1.z, w1.w};
#pragma unroll
        for (int i = 0; i < 8; ++i) wv[i] = (s0 + i <= t) ? wv[i] * rs[s0 + i] : 0.f;
        u32x4 aw; aw.x = pk2(wv[0], wv[1]); aw.y = pk2(wv[2], wv[3]); aw.z = pk2(wv[4], wv[5]); aw.w = pk2(wv[6], wv[7]);
        const bf16x8 af = asbf(aw);
#pragma unroll
        for (int nt = 0; nt < 16; ++nt) { const bf16x8 bfr = asbf(*(const u32x4*)(lds + (nt * 16 + r) * LROW + s0 * 2)); acc[nt] = mfma16(bfr, af, acc[nt]); }
    }
    const int tok = bn * 128 + t;
    const float bt = p.bs_gmlp[((size_t)l * 4 + g) * 128 + t];
    const float* gain = p.vnorm + (size_t)l * 1024 + g * 256;
    bf16_t* up = ubuf + (size_t)tok * 1024 + g * 256;
    u32x2 uall[16]; f32x4 gall[16];
#pragma unroll
    for (int nt = 0; nt < 16; ++nt) { const int c = nt * 16 + q4 * 4; uall[nt] = *(const u32x2*)(up + c); gall[nt] = *(const f32x4*)(gain + c); }
    asm volatile("" ::: "memory");
#pragma unroll
    for (int nt = 0; nt < 16; ++nt) { const int c = nt * 16 + q4 * 4;
        const f32x4 gn = gall[nt];
        const u32x2 uw = uall[nt];
        const float y0 = gelu_tanh(bflo(uw.x)) * (acc[nt][0] * gn.x + bt), y1 = gelu_tanh(bfhi(uw.x)) * (acc[nt][1] * gn.y + bt), y2 = gelu_tanh(bflo(uw.y)) * (acc[nt][2] * gn.z + bt), y3 = gelu_tanh(bfhi(uw.y)) * (acc[nt][3] * gn.w + bt);
        u32x2 o; o.x = pk2(y0, y1); o.y = pk2(y2, y3); *(u32x2*)(up + c) = o; }
}

__device__ __forceinline__ void kv_item(const Params& p, int bnh, unsigned char* lds, int tid, int wave, int lane, int dslot = 6) {
    const int r = lane & 15, q4 = lane >> 4;
    const int h = bnh & 3, bn = bnh >> 2;
    const bf16_t* qk = (const bf16_t*)(p.ws + SLOTP(1));
    const bf16_t* vT = (const bf16_t*)(p.ws + SLOTP(4)) + ((size_t)bn * 1024 + h * 256) * 128;
    (void)dslot; bf16_t* kvT = KVBASE(p) + (size_t)bnh * 32768;
    const float lg = log_gamma(h);
    __syncthreads();
    { const int j0 = (tid & 63) * 2, f0 = (tid >> 6) * 8;
      const int tok = bn * 128 + j0;
      const bf16_t* kp = qk + (size_t)tok * 1024 + 512 + h * 128 + f0;
      const u32x4 lo0 = *(const u32x4*)kp, hi0 = *(const u32x4*)(kp + 64), lo1 = *(const u32x4*)(kp + 1024), hi1 = *(const u32x4*)(kp + 1024 + 64);
      const float sc0 = 0.08838834764831845f * __expf(lg * (float)(127 - j0)), sc1 = 0.08838834764831845f * __expf(lg * (float)(126 - j0));
      u32x4 a0, b0, a1, b1; rot8(lo0, hi0, (float)p.pos[tok], f0, sc0, a0, b0); rot8(lo1, hi1, (float)p.pos[tok + 1], f0, sc1, a1, b1);
      const unsigned A0[4] = {a0.x, a0.y, a0.z, a0.w}, B0[4] = {b0.x, b0.y, b0.z, b0.w}, A1[4] = {a1.x, a1.y, a1.z, a1.w}, B1[4] = {b1.x, b1.y, b1.z, b1.w};
      unsigned* d0 = (unsigned*)(lds + f0 * LROW + j0 * 2); unsigned* d1 = (unsigned*)(lds + (64 + f0) * LROW + j0 * 2);
#pragma unroll
      for (int i = 0; i < 4; ++i) {
          d0[(2 * i) * (LROW / 4)] = (A0[i] & 0xffffu) | (A1[i] << 16); d0[(2 * i + 1) * (LROW / 4)] = (A0[i] >> 16) | (A1[i] & 0xffff0000u);
          d1[(2 * i) * (LROW / 4)] = (B0[i] & 0xffffu) | (B1[i] << 16); d1[(2 * i + 1) * (LROW / 4)] = (B0[i] >> 16) | (B1[i] & 0xffff0000u); }
    }
    bf16x8 af[2][4];
#pragma unroll
    for (int mt = 0; mt < 2; ++mt)
#pragma unroll
        for (int kk = 0; kk < 4; ++kk) af[mt][kk] = asbf(*(const u32x4*)(vT + (size_t)(wave * 32 + mt * 16 + r) * 128 + kk * 32 + q4 * 8));
    __syncthreads();
#ifdef KVDUMP
    { const u32x4* src = (const u32x4*)(lds + tid * 64); u32x4* dst = (u32x4*)(kvT + tid * 32);
      dst[0] = src[0]; dst[1] = src[1]; dst[2] = src[2]; dst[3] = src[3];
      u32x4* dst2 = (u32x4*)(kvT + 16384 + tid * 32);
      dst2[0] = __builtin_bit_cast(u32x4, af[0][0]); dst2[1] = __builtin_bit_cast(u32x4, af[0][1]); dst2[2] = __builtin_bit_cast(u32x4, af[1][2]); dst2[3] = __builtin_bit_cast(u32x4, af[1][3]); return; }
#endif
    f32x4 acc[2][8];
#pragma unroll
    for (int mt = 0; mt < 2; ++mt)
#pragma unroll
        for (int nt = 0; nt < 8; ++nt) acc[mt][nt] = (f32x4){0.f, 0.f, 0.f, 0.f};
#pragma unroll
    for (int kk = 0; kk < 4; ++kk)
#pragma unroll
        for (int nt = 0; nt < 8; ++nt) { const bf16x8 bfr = asbf(*(const u32x4*)(lds + (nt * 16 + r) * LROW + (kk * 32 + q4 * 8) * 2));
            acc[0][nt] = mfma16(bfr, af[0][kk], acc[0][nt]); acc[1][nt] = mfma16(bfr, af[1][kk], acc[1][nt]); }
#pragma unroll
    for (int mt = 0; mt < 2; ++mt)
#pragma unroll
        for (int nt = 0; nt < 8; ++nt) { u32x2 o; o.x = pk2(acc[mt][nt][0], acc[mt][nt][1]); o.y = pk2(acc[mt][nt][2], acc[mt][nt][3]);
            *(u32x2*)(kvT + (size_t)(wave * 32 + mt * 16 + r) * 128 + nt * 16 + q4 * 4) = o; }
}

__device__ __forceinline__ void ret_item(const Params& p, int bnh, unsigned char* lds, int tid, int wave, int lane) {
    const int r = lane & 15, q4 = lane >> 4;
    const int h = bnh & 3, bn = bnh >> 2;
    const bf16_t* qk = (const bf16_t*)(p.ws + SLOTP(1));
    const bf16_t* vT = (const bf16_t*)(p.ws + SLOTP(4)) + ((size_t)bn * 1024 + h * 256) * 128;
    const bf16_t* prevT = KVBASE(p) + (size_t)bnh * 32768;
    bf16_t* gbuf = (bf16_t*)(p.ws + SLOTP(2));
    unsigned char* ldsK = lds; unsigned char* ldsV = lds + 128 * LROW;
    const float lg = log_gamma(h);
    __syncthreads();
    stage_rows128(ldsV, prevT, 256, tid);
    __builtin_amdgcn_sched_barrier(0);
#pragma unroll
    for (int ps = 0; ps < 2; ++ps) { const int t = ps * 512 + tid, cgi = t & 7, j = t >> 3, f0 = cgi * 8;
        const int tok = bn * 128 + j;
        const bf16_t* kp = qk + (size_t)tok * 1024 + 512 + h * 128 + f0;
        const u32x4 lo = *(const u32x4*)kp, hi = *(const u32x4*)(kp + 64);
        u32x4 olo, ohi; rot8(lo, hi, (float)p.pos[tok], f0, 0.08838834764831845f, olo, ohi);
        *(u32x4*)(ldsK + j * LROW + f0 * 2) = olo; *(u32x4*)(ldsK + j * LROW + (64 + f0) * 2) = ohi; }
    __builtin_amdgcn_sched_barrier(0);
    const int irow = wave * 16 + r, tokq = bn * 128 + irow;
    bf16x8 qf[4];
    { const bf16_t* qp = qk + (size_t)tokq * 1024 + h * 128 + q4 * 8;
      const u32x4 q0 = *(const u32x4*)qp, q1 = *(const u32x4*)(qp + 32), q2 = *(const u32x4*)(qp + 64), q3 = *(const u32x4*)(qp + 96);
      const float ps = (float)p.pos[tokq];
      u32x4 o0, o1, o2, o3; rot8(q0, q2, ps, q4 * 8, 1.0f, o0, o2); rot8(q1, q3, ps, 32 + q4 * 8, 1.0f, o1, o3);
      qf[0] = asbf(o0); qf[1] = asbf(o1); qf[2] = asbf(o2); qf[3] = asbf(o3); }
    __syncthreads();
    const int nkk2 = (wave >> 1) + 1;
    bf16x8 pf[4];
#pragma unroll
    for (int kk2 = 0; kk2 < 4; ++kk2) {
        u32x4 pw = {0u, 0u, 0u, 0u};
        if (kk2 < nkk2) {
#pragma unroll
            for (int hh = 0; hh < 2; ++hh) { const int nt = kk2 * 2 + hh;
                f32x4 s = {0.f, 0.f, 0.f, 0.f};
#pragma unroll
                for (int kk = 0; kk < 4; ++kk) { const bf16x8 kf = asbf(*(const u32x4*)(ldsK + (nt * 16 + r) * LROW + (kk * 32 + q4 * 8) * 2)); s = mfma16(kf, qf[kk], s); }
                float pv[4];
#pragma unroll
                for (int i = 0; i < 4; ++i) { const int j = nt * 16 + q4 * 4 + i; const int dlt = irow - j; pv[i] = dlt >= 0 ? s[i] * __expf(lg * (float)dlt) : 0.f; }
                if (hh == 0) { pw.x = pk2(pv[0], pv[1]); pw.y = pk2(pv[2], pv[3]); } else { pw.z = pk2(pv[0], pv[1]); pw.w = pk2(pv[2], pv[3]); } }
        }
        pf[kk2] = asbf(pw);
        __builtin_amdgcn_sched_barrier(0);
    }
    f32x4 acc[16];
#pragma unroll
    for (int i = 0; i < 16; ++i) acc[i] = (f32x4){0.f, 0.f, 0.f, 0.f};
    if ((bn & 15) != 0) {
#pragma unroll
        for (int kk = 0; kk < 4; ++kk) {
#pragma unroll
            for (int nt = 0; nt < 16; ++nt) { const bf16x8 bfr = asbf(*(const u32x4*)(ldsV + (nt * 16 + r) * LROW + (kk * 32 + q4 * 8) * 2)); acc[nt] = mfma16(bfr, qf[kk], acc[nt]); }
            __builtin_amdgcn_sched_barrier(0); }
        const float dq = __expf(lg * (float)(irow + 1));
#pragma unroll
        for (int nt = 0; nt < 16; ++nt) acc[nt] = acc[nt] * dq;
    }
    __syncthreads();
    stage_rows128(ldsV, vT, 256, tid);
    __syncthreads();
    for (int kk2 = 0; kk2 < nkk2; ++kk2) {
        const bf16x8 pa = kk2 == 0 ? pf[0] : (kk2 == 1 ? pf[1] : (kk2 == 2 ? pf[2] : pf[3]));
#pragma unroll
        for (int nt = 0; nt < 16; ++nt) { const unsigned char* vp = ldsV + (nt * 16 + r) * LROW + (kk2 * 32 + q4 * 4) * 2;
            const u32x2 v0 = *(const u32x2*)vp, v1 = *(const u32x2*)(vp + 32);
            u32x4 vv; vv.x = v0.x; vv.y = v0.y; vv.z = v1.x; vv.w = v1.y;
            acc[nt] = mfma16(asbf(vv), pa, acc[nt]); }
    }
    float ss = 0.f;
#pragma unroll
    for (int nt = 0; nt < 16; ++nt) ss += (acc[nt][0] * acc[nt][0] + acc[nt][1] * acc[nt][1]) + (acc[nt][2] * acc[nt][2] + acc[nt][3] * acc[nt][3]);
    ss += __shfl_xor(ss, 16); ss += __shfl_xor(ss, 32);
    const float rstd = rsqrtf(ss * (1.f / 256.f) + EPS);
    bf16_t* gp = gbuf + (size_t)tokq * 1024 + h * 256 + q4 * 4;
    u32x2 gall[16];
#pragma unroll
    for (int nt = 0; nt < 16; ++nt) gall[nt] = *(const u32x2*)(gp + nt * 16);
    asm volatile("" ::: "memory");
#pragma unroll
    for (int nt = 0; nt < 16; ++nt) { const u32x2 gw = gall[nt];
        u32x2 o; o.x = pk2(siluf_(bflo(gw.x)) * acc[nt][0] * rstd, siluf_(bfhi(gw.x)) * acc[nt][1] * rstd); o.y = pk2(siluf_(bflo(gw.y)) * acc[nt][2] * rstd, siluf_(bfhi(gw.y)) * acc[nt][3] * rstd);
        *(u32x2*)(gp + nt * 16) = o; }
}

template <int W>
__device__ __forceinline__ void pooled_task(const bf16_t* pb, bf16_t* ob, int cgi, int seg) {
    const int row0 = seg * 16, s0 = row0 & (SEQ - 1);
    const bf16_t* base = pb + (size_t)row0 * 1024 + cgi * 8;
    u32x4 R[W - 1 + 16];
#pragma unroll
    for (int i = 0; i < W - 1 + 16; ++i) { const int rel = i - (W - 1);
        R[i] = (s0 + rel >= 0) ? *(const u32x4*)(base + (ptrdiff_t)rel * 1024) : (u32x4){0u, 0u, 0u, 0u}; }
    float S[8];
#pragma unroll
    for (int k = 0; k < 8; ++k) S[k] = 0.f;
#pragma unroll
    for (int i = 0; i < W - 1; ++i) { const u32x4 v = R[i];
        S[0] += bflo(v.x); S[1] += bfhi(v.x); S[2] += bflo(v.y); S[3] += bfhi(v.y); S[4] += bflo(v.z); S[5] += bfhi(v.z); S[6] += bflo(v.w); S[7] += bfhi(v.w); }
#pragma unroll
    for (int t = 0; t < 16; ++t) {
        const int s = s0 + t;
        const u32x4 v = R[W - 1 + t];
        const float c[8] = {bflo(v.x), bfhi(v.x), bflo(v.y), bfhi(v.y), bflo(v.z), bfhi(v.z), bflo(v.w), bfhi(v.w)};
        const float inv = 1.0f / (float)min(s + 1, W);
        float o[8];
#pragma unroll
        for (int k = 0; k < 8; ++k) { S[k] += c[k]; o[k] = S[k] * inv - c[k]; }
        u32x4 ow; ow.x = pk2(o[0], o[1]); ow.y = pk2(o[2], o[3]); ow.z = pk2(o[4], o[5]); ow.w = pk2(o[6], o[7]);
        *(u32x4*)(ob + (size_t)(row0 + t) * 1024 + cgi * 8) = ow;
        const u32x4 x = R[t];
        S[0] -= bflo(x.x); S[1] -= bfhi(x.x); S[2] -= bflo(x.y); S[3] -= bfhi(x.y); S[4] -= bflo(x.z); S[5] -= bfhi(x.z); S[6] -= bflo(x.w); S[7] -= bfhi(x.w);
    }
}
__device__ __forceinline__ void pooled_tasks(const Params& p, int gtid, int nthr) {
    const bf16_t* pb = (const bf16_t*)(p.ws + SLOTP(5));
    bf16_t* ob = (bf16_t*)(p.ws + SLOTP(0));
    for (int task = gtid; task < 131072; task += nthr) {
        const int g = (task >> 6) & 3, cgi = g * 32 + (task & 31), seg = ((task >> 8) << 1) | ((task >> 5) & 1);
        if (g == 0) pooled_task<2>(pb, ob, cgi, seg); else if (g == 1) pooled_task<4>(pb, ob, cgi, seg); else if (g == 2) pooled_task<8>(pb, ob, cgi, seg); else pooled_task<16>(pb, ob, cgi, seg);
    }
}
__device__ __forceinline__ void scan_tasks(const Params& p, int gtid, int nthr) {
    bf16_t* kv = KVBASE(p);
    for (int task = gtid; task < 131072; task += nthr) {
        const int o = task & 4095, bh = task >> 12, b = bh >> 2, h = bh & 3;
        const float dc = __expf(log_gamma(h) * 128.0f);
        float st[8];
#pragma unroll
        for (int i = 0; i < 8; ++i) st[i] = 0.f;
        u32x4 v[16];
#pragma unroll
        for (int n = 0; n < 16; ++n) v[n] = *(const u32x4*)(kv + ((size_t)((b * 16 + n) * 4 + h)) * 32768 + o * 8);
#pragma unroll
        for (int n = 0; n < 16; ++n) {
            u32x4 ow; ow.x = pk2(st[0], st[1]); ow.y = pk2(st[2], st[3]); ow.z = pk2(st[4], st[5]); ow.w = pk2(st[6], st[7]);
            *(u32x4*)(kv + ((size_t)((b * 16 + n) * 4 + h)) * 32768 + o * 8) = ow;
            const float c[8] = {bflo(v[n].x), bfhi(v[n].x), bflo(v[n].y), bfhi(v[n].y), bflo(v[n].z), bfhi(v[n].z), bflo(v[n].w), bfhi(v[n].w)};
#pragma unroll
            for (int i = 0; i < 8; ++i) st[i] = dc * st[i] + c[i];
        }
    }
}


#define XB_TMO      128
#define XB_XCNT(j)  (256  + 64 * (j))
#define XB_XSUB(j)  (1280 + 64 * (j))
#define XB_XGEN(j)  (2304 + 64 * (j))
#define XB_TOP      3328
#define XB_TOPGEN   3392
#define XCD_BAR_WORDS 3456
#define XB_SPIN_CAP (1u << 18)
__device__ __forceinline__ unsigned xb_ld(unsigned* p)              { return __hip_atomic_load(p, __ATOMIC_RELAXED, __HIP_MEMORY_SCOPE_AGENT); }
__device__ __forceinline__ unsigned xb_add(unsigned* p, unsigned v) { return __hip_atomic_fetch_add(p, v, __ATOMIC_RELAXED, __HIP_MEMORY_SCOPE_AGENT); }
__device__ __forceinline__ unsigned xb_xcc_id() { return (unsigned)__builtin_amdgcn_s_getreg((3 << 11) | 20) & 0xFu; }
#define XB_SPIN(cond, bar) do { unsigned _sp = 0; while (cond) { __builtin_amdgcn_s_sleep(1); \
    if ((++_sp & 255u) == 0u) { if (xb_ld(&(bar)[XB_TMO])) break; if (_sp > XB_SPIN_CAP) { atomicAdd(&(bar)[XB_TMO], 1u); break; } } } } while (0)
struct XcdBarrier { unsigned* bar; unsigned x; volatile LAS unsigned* st; };
__device__ __forceinline__ void xcd_barrier_complete(unsigned* bar, unsigned x, unsigned& nloc, unsigned& nx) {
    const unsigned G = gridDim.x * gridDim.y * gridDim.z;
    unsigned sum, cnt, mine, sp = 0u;
    for (;;) {
        sum = 0u; cnt = 0u; mine = 0u;
#pragma unroll
        for (unsigned j = 0; j < 16; ++j) { const unsigned c = xb_ld(&bar[XB_XCNT(j)]); sum += c; cnt += (c > 0u) ? 1u : 0u; mine = (j == x) ? c : mine; }
        if (sum == G) break;
        __builtin_amdgcn_s_sleep(1);
        if ((++sp & 255u) == 0u) { if (xb_ld(&bar[XB_TMO])) break; if (sp > XB_SPIN_CAP) { atomicAdd(&bar[XB_TMO], 1u); break; } }
    }
    nloc = mine > 0u ? mine : 1u; nx = cnt > 0u ? cnt : 1u;
}
__device__ __forceinline__ void xcd_barrier(const XcdBarrier& b) {
    asm volatile("s_waitcnt vmcnt(0)" ::: "memory");
    __syncthreads();
    if (threadIdx.x == 0) {
        unsigned* bar = b.bar;
        __builtin_amdgcn_s_waitcnt(0);
        unsigned nloc = b.st[0], nx = b.st[1];
        if (nloc == 0u) { xcd_barrier_complete(bar, b.x, nloc, nx); b.st[0] = nloc; b.st[1] = nx; }
        const unsigned old = xb_add(&bar[XB_XSUB(b.x)], 1u);
        const unsigned gen = old / nloc;
        if (old + 1u == (gen + 1u) * nloc) {
            __builtin_amdgcn_fence(__ATOMIC_RELEASE, "agent");
            asm volatile("s_waitcnt vmcnt(0)" ::: "memory");
            const unsigned og = xb_add(&bar[XB_TOP], 1u);
            const unsigned tg = og / nx;
            if (og + 1u == (tg + 1u) * nx) xb_add(&bar[XB_TOPGEN], 1u);
            else XB_SPIN(xb_ld(&bar[XB_TOPGEN]) == tg, bar);
            __builtin_amdgcn_fence(__ATOMIC_ACQUIRE, "agent");
            xb_add(&bar[XB_XGEN(b.x)], 1u);
            asm volatile("s_waitcnt vmcnt(0)" ::: "memory");
        } else {
            XB_SPIN(xb_ld(&bar[XB_XGEN(b.x)]) == gen, bar);
            __builtin_amdgcn_fence(__ATOMIC_ACQUIRE, "agent");
            asm volatile("s_waitcnt vmcnt(0)" ::: "memory");
        }
    }
    __syncthreads();
}
__device__ __forceinline__ void gsync(cg::grid_group& g) {
    asm volatile("s_waitcnt vmcnt(0)" ::: "memory");
    __syncthreads();
    if (threadIdx.x < 64) { __builtin_amdgcn_fence(__ATOMIC_RELEASE, "agent"); asm volatile("s_waitcnt vmcnt(0)" ::: "memory"); }
    g.sync();
    if (threadIdx.x < 64) { __builtin_amdgcn_fence(__ATOMIC_ACQUIRE, "agent"); asm volatile("s_waitcnt vmcnt(0)" ::: "memory"); }
    __syncthreads();
}
#ifndef SKIPMASK
#define SKIPMASK 0
#endif
#define PH(n) if (!((SKIPMASK >> (n)) & 1) && ph >= ph_lo && ph < ph_hi)
__global__ void __launch_bounds__(512, 2) fwd_megakernel(Params pk_unused) {
    extern __shared__ __attribute__((aligned(16))) unsigned char shm[];
    cg::grid_group grid = cg::this_grid();
    LAS unsigned char* ldsl = (LAS unsigned char*)shm;
    typedef const __attribute__((address_space(4))) Params* KArgP;
    int ph = 0; const int ph_lo = pk_unused.ph_lo, ph_hi = pk_unused.ph_hi;
    volatile LAS unsigned* xst = (volatile LAS unsigned*)(ldsl + 131072);
    if (threadIdx.x == 0) { xst[0] = 0u; xst[1] = 0u; }
    __syncthreads();
    if (threadIdx.x == 0) (void)xb_add(&((unsigned*)(pk_unused.ws + OFF_BAR))[XB_XCNT(xb_xcc_id())], 1u);
#define SEAM() do { ++ph; if (ph > ph_lo && ph < ph_hi) { if (ph_hi == 0x7fffffff) gsync(grid); else { KArgP kq = (KArgP)__builtin_amdgcn_kernarg_segment_ptr(); asm volatile("" : "+s"(kq)); \
        XcdBarrier xbb; xbb.bar = (unsigned*)(kq->ws + OFF_BAR); xbb.x = xb_xcc_id(); xbb.st = xst; xcd_barrier(xbb); } } } while (0)
#define CTX() int tid = threadIdx.x; asm volatile("" : "+v"(tid)); int bid = blockIdx.x; asm volatile("" : "+s"(bid)); int G = gridDim.x; asm volatile("" : "+s"(G)); \
    KArgP kp = (KArgP)__builtin_amdgcn_kernarg_segment_ptr(); asm volatile("" : "+s"(kp)); Params p; p.x = kp->x; p.c = kp->c; p.pos = kp->pos; p.w_ada = kp->w_ada; p.b_ada = kp->b_ada; p.norm1 = kp->norm1; p.norm2 = kp->norm2; p.w_in = kp->w_in; p.ws_gmlp = kp->ws_gmlp; \
    p.bs_gmlp = kp->bs_gmlp; p.vnorm = kp->vnorm; p.w_pool = kp->w_pool; p.b_pool = kp->b_pool; p.pool_scale = kp->pool_scale; p.w_branch = kp->w_branch; p.w_out = kp->w_out; p.w_ff1 = kp->w_ff1; \
    p.w_ff2 = kp->w_ff2; p.final_norm = kp->final_norm; p.out = kp->out; p.ws = kp->ws; p.ph_lo = kp->ph_lo; p.ph_hi = kp->ph_hi; unsigned char* const wsq = p.ws; \
    const int lane = tid & 63, wave = __builtin_amdgcn_readfirstlane(tid >> 6), gtid = bid * 512 + tid, gw = bid * 8 + wave, nthr = G * 512, ngw = G * 8; \
    float* mod = (float*)(wsq + OFF_MOD); float* sumsq = (float*)(wsq + OFF_SUMSQ); (void)lane; (void)wave; (void)gtid; (void)gw; (void)nthr; (void)ngw; (void)mod; (void)sumsq;
#define LCTX() const float* xin = (l == 0) ? p.x : p.out; const float* modl = mod + (size_t)l * 8 * 6144; (void)xin; (void)modl;

    PH(0) {
        CTX();
        float* cact = (float*)shm;
        for (int i = tid; i < 8192; i += 512) { const float v = p.c[i]; cact[i] = siluf_(v); }
        __syncthreads();
        float* modpart = (float*)(p.ws + SLOTP(1));
        for (int t = gtid; t < 98304; t += nthr) {
            const int cg4 = t % 1536, rest = t / 1536, ks = rest & 31, l = rest >> 5;
            f32x4 a[8];
#pragma unroll
            for (int b = 0; b < 8; ++b) a[b] = (f32x4){0.f, 0.f, 0.f, 0.f};
            const float* w = p.w_ada + ((size_t)l * 1024 + ks * 32) * 6144 + cg4 * 4;
#pragma unroll 8
            for (int k = 0; k < 32; ++k) { const f32x4 wv = __builtin_nontemporal_load((const f32x4*)(w + (size_t)k * 6144));
#pragma unroll
                for (int b = 0; b < 8; ++b) a[b] += wv * cact[b * 1024 + ks * 32 + k]; }
#pragma unroll
            for (int b = 0; b < 8; ++b) *(f32x4*)(modpart + ((size_t)((ks * 2 + l) * 8 + b)) * 6144 + cg4 * 4) = a[b];
        }
        __syncthreads();
        conv_set(p, 0, 0, shm, gw, ngw, wave, lane);
    }
    SEAM();
    PH(0) {
        CTX();
        const float* modpart = (const float*)(p.ws + SLOTP(1));
        for (int idx = gtid; idx < 98304; idx += nthr) {
            const int l = idx / 49152, rem = idx - l * 49152, b = rem / 6144, col = rem - b * 6144;
            float s = p.b_ada[l * 6144 + col];
            for (int ks = 0; ks < 32; ++ks) s += modpart[((size_t)((ks * 2 + l) * 8 + b)) * 6144 + col];
            mod[idx] = s;
        }
    }
    SEAM();

#pragma nounroll
    for (int lq = 0; lq < 2; ++lq) {
        int l = lq; asm volatile("" : "+s"(l));
        PH(1) {
            CTX(); LCTX();
            if (l == 0) norm_rows(p.x, (bf16_t*)(p.ws + SLOTP(7)), p.norm1 + l * 1024, modl, gw, ngw, lane);
            else norm_rows_b((const bf16_t*)p.out, (bf16_t*)(p.ws + SLOTP(7)), p.norm1 + l * 1024, modl, gw, ngw, lane);
            for (int i = gtid; i < MTOK; i += nthr) sumsq[i] = 0.f;
            if (l == 1) conv_set(p, 1, 0, shm, gw, ngw, wave, lane);
        }
        SEAM();
        PH(2) {
            CTX(); LCTX();
            pg8::PlainSched S; S.so.init(64, 16, G, bid); S.A = (const char*)(p.ws + SLOTP(7)); S.B = (const char*)(p.ws + OFF_WIN); S.tA = 256 * 1024 * 2; S.tB = 256 * 1024 * 2;
            EpiIn E; E.slots = p.ws + OFF_SLOTS;
            PH(13) pg8::gemm_phase(ldsl, pg8::Gemm{1024, 1024, 1024}, S, E);
        }
        PH(2) {
            CTX(); LCTX();
            pg8::PlainSched T; T.so.init(8, 64, G, bid); T.A = (const char*)(p.ws + OFF_WIN) + (size_t)4096 * 2048; T.B = (const char*)(p.ws + SLOTP(7)); T.tA = 256 * 1024 * 2; T.tB = 256 * 1024 * 2;
            EpiInT ET; ET.vT = (bf16_t*)(p.ws + SLOTP(4)); ET.vsT = (bf16_t*)(p.ws + SLOTP(6)); ET.sumsq = sumsq;
            PH(14) pg8::gemm_phase(ldsl, pg8::Gemm{1024, 1024, 1024}, T, ET);
        }
        SEAM();
        PH(3) { CTX(); LCTX(); for (int it = bid; it < 512; it += G) sgu_item(p, l, it >> 2, it & 3, shm, tid, wave, lane); }
        PH(4) { CTX(); LCTX(); pooled_tasks(p, gtid, nthr); }
        PH(5) { CTX(); LCTX(); for (int it = bid; it < 512; it += G) kv_item(p, it, shm, tid, wave, lane); }
        __syncthreads();
        PH(1) { CTX(); LCTX(); conv_set(p, l, 1, shm, gw, ngw, wave, lane); }
        SEAM();
        PH(6) {
            CTX(); LCTX();
            PoolSched S; S.G = G; S.c = bid; S.pooled = (const char*)(p.ws + SLOTP(0)); S.wp = (const char*)(p.ws + OFF_WPOOL);
            EpiPool E; E.y = (bf16_t*)(p.ws + SLOTP(0)); E.bias = p.b_pool + l * 1024; E.scale = p.pool_scale + l * 1024;
            pg8::gemm_phase(ldsl, pg8::Gemm{1024, 256, 256}, S, E);
        }
        PH(7) { CTX(); LCTX(); scan_tasks(p, gtid, nthr); }
        SEAM();
        PH(8) { CTX(); LCTX(); for (int it = bid; it < 512; it += G) ret_item(p, it, shm, tid, wave, lane); }
        __syncthreads();
        SEAM();
        PH(9) {
            CTX(); LCTX();
            BranchSched S; S.so.init(64, 4, G, bid); S.h = (const char*)(p.ws + SLOTP(7)); S.wg = (const char*)(p.ws + OFF_WIN) + (size_t)6144 * 2048;
            S.slots = (const char*)(p.ws + OFF_SLOTS); S.wb = (const char*)(p.ws + OFF_WBR);
            EpiBranch E; E.gcur = (bf16_t*)(p.ws + SLOTP(1)); E.tmp = (bf16_t*)(p.ws + SLOTP(5)); E.merged = (bf16_t*)(p.ws + SLOTP(4));
            pg8::gemm_phase(ldsl, pg8::Gemm{1024, 1024, 1024}, S, E);
        }
        SEAM();
        PH(10) {
            CTX(); LCTX();
            pg8::PlainSched S; S.so.init(64, 4, G, bid); S.A = (const char*)(p.ws + SLOTP(4)); S.B = (const char*)(p.ws + OFF_WOUT); S.tA = 256 * 1024 * 2; S.tB = 256 * 1024 * 2;
            EpiResidB E; E.xf = p.x; E.xb = (const bf16_t*)p.out; E.xdst = (bf16_t*)p.out; E.gate = modl + 2048; E.src_f32 = (l == 0) ? 1 : 0;
            pg8::gemm_phase(ldsl, pg8::Gemm{1024, 1024, 1024}, S, E);
        }
        SEAM();
        PH(1) {
            CTX(); LCTX();
            norm_rows_b((const bf16_t*)p.out, (bf16_t*)(p.ws + SLOTP(7)), p.norm2 + l * 1024, modl + 3072, gw, ngw, lane);
            conv_set(p, l, 2, shm, gw, ngw, wave, lane);
        }
        SEAM();
        PH(11) {
            CTX(); LCTX();
            pg8::PlainSched S; S.so.init(64, 16, G, bid); S.A = (const char*)(p.ws + SLOTP(7)); S.B = (const char*)(p.ws + OFF_WFF1); S.tA = 256 * 1024 * 2; S.tB = 256 * 1024 * 2;
            EpiFF1 E; E.hid = (bf16_t*)(p.ws + SLOTP(0));
            pg8::gemm_phase(ldsl, pg8::Gemm{1024, 1024, 1024}, S, E);
        }
        SEAM();
        PH(12) {
            CTX(); LCTX();
            pg8::PlainSched S; S.so.init(64, 4, G, bid); S.A = (const char*)(p.ws + SLOTP(0)); S.B = (const char*)(p.ws + OFF_WFF2); S.tA = (size_t)256 * 4096 * 2; S.tB = (size_t)256 * 4096 * 2;
            EpiResidB E; E.xf = p.x; E.xb = (const bf16_t*)p.out; E.xdst = (l == 1) ? (bf16_t*)(p.ws + SLOTP(4)) : (bf16_t*)p.out; E.gate = modl + 5120; E.src_f32 = 0;
            pg8::gemm_phase(ldsl, pg8::Gemm{4096, 4096, 4096}, S, E);
        }
        SEAM();
    }
    if (ph >= ph_lo && ph < ph_hi) {
        CTX();
        for (int row = gw; row < MTOK; row += ngw) {
            const u32x4* xr = (const u32x4*)((const bf16_t*)(p.ws + SLOTP(4)) + (size_t)row * 1024) + lane;
            float v[2][8]; float s = 0.f;
#pragma unroll
            for (int j = 0; j < 2; ++j) { const u32x4 t = xr[64 * j];
                v[j][0] = bflo(t.x); v[j][1] = bfhi(t.x); v[j][2] = bflo(t.y); v[j][3] = bfhi(t.y); v[j][4] = bflo(t.z); v[j][5] = bfhi(t.z); v[j][6] = bflo(t.w); v[j][7] = bfhi(t.w);
#pragma unroll
                for (int k = 0; k < 8; ++k) s += v[j][k] * v[j][k]; }
            const float rstd = rsqrtf(wave_sum(s) * (1.f / 1024.f) + EPS);
            f32x4 gf[2][2];
#pragma unroll
            for (int j = 0; j < 2; ++j)
#pragma unroll
                for (int q = 0; q < 2; ++q) gf[j][q] = *(const f32x4*)(p.final_norm + (lane + 64 * j) * 8 + 4 * q);
            float* orow = p.out + (size_t)row * 1024;
#pragma unroll
            for (int j = 0; j < 2; ++j) {
                *(f32x4*)(orow + (lane + 64 * j) * 8) = (f32x4){v[j][0], v[j][1], v[j][2], v[j][3]} * rstd * gf[j][0];
                *(f32x4*)(orow + (lane + 64 * j) * 8 + 4) = (f32x4){v[j][4], v[j][5], v[j][6], v[j][7]} * rstd * gf[j][1]; }
        }
    }
}

constexpr int LDS_BYTES = 131072 + 16;

extern "C" void kernel_launch(void* const* d_in, const int* in_sizes, int n_in, void* d_out, int out_size, void* d_ws, size_t ws_size, hipStream_t stream) {
    static int grid_blocks = 0;
    if (grid_blocks == 0) {
        if (n_in != 19 || ws_size < WS_NEED) { fprintf(stderr, "kernel_launch: need 19 inputs and %zu bytes of workspace; got %d, %zu\n", (size_t)WS_NEED, n_in, ws_size); grid_blocks = -1; return; }
        int dev = 0, cus = 0, per_cu = 0;
        hipGetDevice(&dev);
        hipDeviceGetAttribute(&cus, hipDeviceAttributeMultiprocessorCount, dev);
        hipFuncSetAttribute((const void*)fwd_megakernel, hipFuncAttributeMaxDynamicSharedMemorySize, LDS_BYTES);
        hipOccupancyMaxActiveBlocksPerMultiprocessor(&per_cu, (const void*)fwd_megakernel, 512, LDS_BYTES);
        if (per_cu < 1) { fprintf(stderr, "kernel_launch: occupancy query reports %d blocks per CU\n", per_cu); per_cu = 1; }
        grid_blocks = cus;
        if (grid_blocks > 256) grid_blocks = 256;
    }
    if (grid_blocks < 0) return;
    if (hipMemsetAsync((unsigned char*)d_ws + OFF_BAR, 0, XCD_BAR_WORDS * 4, stream) != hipSuccess) { fprintf(stderr, "kernel_launch: memset of the barrier words failed\n"); return; }
    Params p{};
    p.x = (const float*)d_in[0]; p.c = (const float*)d_in[1]; p.pos = (const int*)d_in[2];
    p.w_ada = (const float*)d_in[3]; p.b_ada = (const float*)d_in[4]; p.norm1 = (const float*)d_in[5]; p.norm2 = (const float*)d_in[6];
    p.w_in = (const float*)d_in[7]; p.ws_gmlp = (const float*)d_in[8]; p.bs_gmlp = (const float*)d_in[9]; p.vnorm = (const float*)d_in[10];
    p.w_pool = (const float*)d_in[11]; p.b_pool = (const float*)d_in[12]; p.pool_scale = (const float*)d_in[13]; p.w_branch = (const float*)d_in[14];
    p.w_out = (const float*)d_in[15]; p.w_ff1 = (const float*)d_in[16]; p.w_ff2 = (const float*)d_in[17]; p.final_norm = (const float*)d_in[18];
    p.out = (float*)d_out; p.ws = (unsigned char*)d_ws;
#ifndef N_LAUNCHES
#define N_LAUNCHES 1
#endif
    for (int li = 0; li < (N_LAUNCHES == 1 ? 1 : 25); ++li) {
        if (N_LAUNCHES == 1) { p.ph_lo = 0; p.ph_hi = 1000; } else { p.ph_lo = li; p.ph_hi = li + 1; }
        void* args[] = {&p};
        hipError_t e = hipLaunchCooperativeKernel((const void*)fwd_megakernel, dim3(grid_blocks), dim3(512), args, LDS_BYTES, stream);
        if (e != hipSuccess) { fprintf(stderr, "cooperative launch failed: %s (grid %d)\n", hipGetErrorString(e), grid_blocks); break; }
    }
}
```

```cpp
#include <hip/hip_runtime.h>
#include <hip/hip_cooperative_groups.h>
#include <cstdio>
#include <cstdint>
namespace cg = cooperative_groups;

#define LAS __attribute__((address_space(3)))
typedef unsigned short bf16_t;
typedef short bf16x8 __attribute__((ext_vector_type(8)));
typedef float f32x4 __attribute__((ext_vector_type(4)));
typedef float f32x2 __attribute__((ext_vector_type(2)));
typedef unsigned u32x4 __attribute__((ext_vector_type(4)));
typedef unsigned u32x2 __attribute__((ext_vector_type(2)));

constexpr int MTOK = 16384, DM = 1024, SEQ = 2048, NB = 8, DFF = 4096, DIN = 9216;
constexpr float EPS = 1e-6f;

constexpr size_t OFF_MOD = 4096;
constexpr size_t OFF_SUMSQ = OFF_MOD + 393216;
constexpr size_t OFF_WIN = OFF_SUMSQ + 65536;
constexpr size_t OFF_WPOOL = OFF_WIN + 18874368;
constexpr size_t OFF_WBR = OFF_WPOOL + 524288;
constexpr size_t OFF_WOUT = OFF_WBR + 6291456;
constexpr size_t OFF_WFF1 = OFF_WIN;
constexpr size_t OFF_WFF2 = OFF_WIN + 8388608;
constexpr size_t OFF_SLOTS = OFF_WOUT + 2097152;
constexpr size_t SLOT = 33554432;
constexpr size_t OFF_BAR = OFF_SLOTS + 8 * SLOT;
constexpr size_t WS_NEED = OFF_BAR + 16384;
#define SLOTP(i) (OFF_SLOTS + (size_t)(i) * SLOT)

struct Params {
    const float *x, *c; const int* pos;
    const float *w_ada, *b_ada, *norm1, *norm2, *w_in, *ws_gmlp, *bs_gmlp, *vnorm, *w_pool, *b_pool, *pool_scale, *w_branch, *w_out, *w_ff1, *w_ff2, *final_norm;
    float* out; unsigned char* ws;
    int ph_lo, ph_hi;
};

typedef __bf16 bf16x2_t __attribute__((ext_vector_type(2)));
__device__ __forceinline__ unsigned pk2(float lo, float hi) { f32x2 v = {lo, hi}; return __builtin_bit_cast(unsigned, __builtin_convertvector(v, bf16x2_t)); }
__device__ __forceinline__ float bflo(unsigned u) { return __uint_as_float(u << 16); }
__device__ __forceinline__ float bfhi(unsigned u) { return __uint_as_float(u & 0xffff0000u); }
__device__ __forceinline__ float wave_sum(float v) {
#pragma unroll
    for (int o = 1; o < 64; o <<= 1) v += __shfl_xor(v, o);
    return v;
}
__device__ __forceinline__ float sigmoidf_(float x) { return __builtin_amdgcn_rcpf(1.0f + __expf(-x)); }
__device__ __forceinline__ float siluf_(float x) { return x * sigmoidf_(x); }
__device__ __forceinline__ float gelu_tanh(float x) { const float u = 1.5957691216057308f * (x + 0.044715f * x * x * x); return x * sigmoidf_(u); }
#define LDS_WAIT() asm volatile("s_waitcnt lgkmcnt(0)" ::: "memory")

namespace pg8 {
constexpr int BM = 256, BK = 64, HALF = 128, HTB = HALF * BK * 2, STAGE_BYTES = 8 * HTB, NXCD = 8, WGM = 8;
__host__ __device__ __forceinline__ int lds_byte(int r, int c) { const int st = (r >> 4) * 2 + (c >> 5), rr = r & 15, cc = c & 31, ob = rr * 64 + cc * 2; return st * 1024 + (ob ^ (((ob >> 9) & 1) << 5)); }
__host__ __device__ __forceinline__ void stage_rc(int b, int& R, int& C) { const int st = b / 1024, sb = b % 1024, swz = sb ^ (((sb >> 9) & 1) << 5); R = (st >> 1) * 16 + swz / 64; C = (st & 1) * 32 + (swz % 64) / 2; }
__host__ __device__ __forceinline__ int perm32(int rho) { const int n = rho >> 4, i = rho & 15; return 8 * (i >> 2) + 4 * n + (i & 3); }

struct Unit { int pm, pn, z; const char* a; const char* b; };
struct Gemm { int lda, ldb, K; };

struct StaticOrder {
    int nM, nN, nwg, G, c;
    __device__ __forceinline__ void init(int nM_, int nN_, int G_, int c_) { nM = nM_; nN = nN_; nwg = nM * nN; G = G_; c = c_; }
    __device__ __forceinline__ bool map(int i, int& pm, int& pn) const {
        const long L = (long)i * G + c; if (L >= nwg) return false;
        int wgid = (int)L; { const int q = nwg / NXCD, r = nwg % NXCD, xcd = wgid % NXCD, off = wgid / NXCD; wgid = (xcd < r ? xcd * (q + 1) : r * (q + 1) + (xcd - r) * q) + off; }
        const int nig = WGM * nN, gid = wgid / nig, fm = gid * WGM, gsz = (nM - fm) < WGM ? (nM - fm) : WGM;
        pm = fm + ((wgid % nig) % gsz); pn = (wgid % nig) / gsz; return true;
    }
};
struct PlainSched {
    StaticOrder so; const char* A; const char* B; size_t tA, tB;
    __device__ __forceinline__ bool next(int i, Unit& u) const { if (!so.map(i, u.pm, u.pn)) return false; u.z = 0; u.a = A + (size_t)u.pm * tA; u.b = B + (size_t)u.pn * tB; return true; }
    __device__ __forceinline__ void a_ready(const Unit&) const {}
    __device__ __forceinline__ void done(const Unit&) const {}
};

template <class Epi, class Sched>
__device__ __forceinline__ void gemm_phase(LAS unsigned char* lds, const Gemm g, const Sched& S, const Epi& E) {
    int tidq = threadIdx.x; asm volatile("" : "+v"(tidq));
    const int tid = tidq, wid = __builtin_amdgcn_readfirstlane(tid >> 6), lane = tid & 63, wr = wid >> 2, wc = wid & 3, fr = lane & 15, fq = lane >> 4;
    int Kq = g.K; asm volatile("" : "+s"(Kq));
    const int K = Kq, nt = K / BK;
    unsigned voffA[2], voffB[2];
#pragma unroll
    for (int i = 0; i < 2; ++i) { int R, C; stage_rc(tid * 16 + i * 8192, R, C); const int Rb = Epi::PERM ? ((R & ~31) + perm32(R & 31)) : R;
        voffA[i] = (unsigned)(R * g.lda + C) * 2u; voffB[i] = (unsigned)(Rb * g.ldb + C) * 2u; }
    const size_t kstep = (size_t)(BK * 2);
    const size_t hstepA = (size_t)HALF * g.lda * 2, hstepB = (size_t)HALF * g.ldb * 2;
    const unsigned ldsw = (unsigned)wid * 1024u;
    const int aoff = lds_byte(wr * 64 + fr, fq * 8), boff = lds_byte(wc * 32 + fr, fq * 8);
#define PG8_SA(b, h) (((b) * 2 + (h)) * HTB)
#define PG8_SB(b, h) ((4 + (b) * 2 + (h)) * HTB)
#define PG8_STAGE(bufoff, gbase, voff) do { _Pragma("unroll") for (int _i = 0; _i < 2; ++_i) \
        __builtin_amdgcn_global_load_lds((const unsigned*)((const char*)(gbase) + (voff)[_i]), (LAS unsigned*)(lds + (bufoff) + ldsw + _i * 8192), 16, 0, 0); } while (0)
#define PG8_LDA(dst, b, h) do { _Pragma("unroll") for (int m = 0; m < 4; ++m) _Pragma("unroll") for (int k = 0; k < 2; ++k) dst[m][k] = *(const LAS bf16x8*)(lds + PG8_SA(b, h) + aoff + m * 2048 + k * 1024); } while (0)
#define PG8_LDB(dst, b, h) do { _Pragma("unroll") for (int n = 0; n < 2; ++n) _Pragma("unroll") for (int k = 0; k < 2; ++k) dst[n][k] = *(const LAS bf16x8*)(lds + PG8_SB(b, h) + boff + n * 2048 + k * 1024); } while (0)
#define PG8_MMA(ai, bj, At, Bt) do { __builtin_amdgcn_s_setprio(1); _Pragma("unroll") for (int m = 0; m < 4; ++m) _Pragma("unroll") for (int n = 0; n < 2; ++n) _Pragma("unroll") for (int k = 0; k < 2; ++k) \
        acc[ai][bj][m][n] = __builtin_amdgcn_mfma_f32_16x16x32_bf16(Bt[n][k], At[m][k], acc[ai][bj][m][n], 0, 0, 0); __builtin_amdgcn_s_setprio(0); } while (0)
#define PG8_WAIT_V(n) asm volatile("s_waitcnt vmcnt(" #n ")" ::: "memory")
#define PG8_WAIT_L(n) asm volatile("s_waitcnt lgkmcnt(" #n ")" ::: "memory")
#define PG8_BAR __builtin_amdgcn_s_barrier()
#define PG8_SCHED __builtin_amdgcn_sched_barrier(0)
    Unit cur, nxt; int ui = 0;
    if (!S.next(0, cur)) return;
    f32x4 acc[2][2][4][2];
#pragma unroll
    for (int a = 0; a < 2; ++a)
#pragma unroll
        for (int b = 0; b < 2; ++b)
#pragma unroll
            for (int m = 0; m < 4; ++m)
#pragma unroll
                for (int n = 0; n < 2; ++n) acc[a][b][m][n] = (f32x4){0.f, 0.f, 0.f, 0.f};
    bf16x8 At[4][2], B0[2][2], B1[2][2];
    const char* cA = cur.a; const char* cB = cur.b;
    S.a_ready(cur);
    PG8_STAGE(PG8_SB(0, 0), cB, voffB); PG8_STAGE(PG8_SB(0, 1), cB + hstepB, voffB); PG8_STAGE(PG8_SA(0, 0), cA, voffA); PG8_STAGE(PG8_SA(0, 1), cA + hstepA, voffA);
    if (wr == 1) PG8_BAR;
    PG8_WAIT_V(2); PG8_BAR;
    PG8_STAGE(PG8_SB(1, 0), cB + kstep, voffB); PG8_STAGE(PG8_SA(1, 0), cA + kstep, voffA); PG8_STAGE(PG8_SB(1, 1), cB + hstepB + kstep, voffB);
    PG8_WAIT_V(6); PG8_BAR;
    for (;;) {
        const bool has_next = S.next(ui + 1, nxt);
        const char* nA = has_next ? nxt.a : cA; const char* nB = has_next ? nxt.b : cB;
        for (int t = 0; t < nt; t += 2) {
            const bool last = (t == nt - 2);
            const char* a1 = cA + (size_t)(t + 1) * kstep;
            const char* a2 = last ? nA : cA + (size_t)(t + 2) * kstep; const char* b2 = last ? nB : cB + (size_t)(t + 2) * kstep;
            const char* a3 = a2 + kstep; const char* b3 = b2 + kstep;
            if (last && has_next) S.a_ready(nxt);
            PG8_LDB(B0, 0, 0); PG8_LDB(B1, 0, 1); PG8_SCHED; PG8_LDA(At, 0, 0); PG8_STAGE(PG8_SA(1, 1), a1 + hstepA, voffA);
            PG8_WAIT_V(8); PG8_WAIT_L(0); PG8_BAR; PG8_MMA(0, 0, At, B0); PG8_MMA(0, 1, At, B1); PG8_BAR; PG8_SCHED;
            PG8_LDA(At, 0, 1); PG8_STAGE(PG8_SB(0, 0), b2, voffB); PG8_STAGE(PG8_SB(0, 1), b2 + hstepB, voffB); PG8_STAGE(PG8_SA(0, 0), a2, voffA);
            PG8_WAIT_V(8); PG8_WAIT_L(0); PG8_BAR; PG8_MMA(1, 0, At, B0); PG8_MMA(1, 1, At, B1); PG8_BAR; PG8_SCHED;
            PG8_LDB(B0, 1, 0); PG8_LDB(B1, 1, 1); PG8_SCHED; PG8_LDA(At, 1, 0); PG8_STAGE(PG8_SA(0, 1), a2 + hstepA, voffA);
            PG8_WAIT_V(8); PG8_WAIT_L(0); PG8_BAR; PG8_MMA(0, 0, At, B0); PG8_MMA(0, 1, At, B1); PG8_BAR; PG8_SCHED;
            PG8_LDA(At, 1, 1); PG8_STAGE(PG8_SB(1, 0), b3, voffB); PG8_STAGE(PG8_SB(1, 1), b3 + hstepB, voffB); PG8_STAGE(PG8_SA(1, 0), a3, voffA);
            PG8_WAIT_V(8); PG8_WAIT_L(0); PG8_BAR; PG8_MMA(1, 0, At, B0); PG8_MMA(1, 1, At, B1); PG8_BAR; PG8_SCHED;
        }
        if (wr == 0) PG8_BAR;
        E(acc, cur, wr, wc, fr, fq); S.done(cur);
        if (!has_next) break;
#pragma unroll
        for (int a = 0; a < 2; ++a)
#pragma unroll
            for (int b = 0; b < 2; ++b)
#pragma unroll
                for (int m = 0; m < 4; ++m)
#pragma unroll
                    for (int n = 0; n < 2; ++n) acc[a][b][m][n] = (f32x4){0.f, 0.f, 0.f, 0.f};
        cur = nxt; cA = nA; cB = nB; ++ui;
        if (wr == 1) PG8_BAR;
    }
    PG8_WAIT_V(0);
    PG8_BAR;
#undef PG8_SA
#undef PG8_SB
#undef PG8_STAGE
#undef PG8_LDA
#undef PG8_LDB
#undef PG8_MMA
#undef PG8_WAIT_V
#undef PG8_WAIT_L
#undef PG8_BAR
#undef PG8_SCHED
}
}
using pg8::Unit;
typedef const f32x4 (&AccRef)[2][2][4][2];

struct EpiIn {
    static constexpr bool PERM = true;
    unsigned char* slots;
    __device__ __forceinline__ void operator()(AccRef acc, const Unit& u, int wr, int wc, int fr, int fq) const {
        const int seg = u.pn >> 2;
        bf16_t* base = (bf16_t*)(slots + (size_t)(seg + 1 + (seg == 3 ? 1 : 0)) * SLOT);
        const int row0 = u.pm * 256 + wr * 64 + fr, col0 = (u.pn & 3) * 256 + wc * 32 + 8 * fq;
#pragma unroll
        for (int ai = 0; ai < 2; ++ai)
#pragma unroll
            for (int m = 0; m < 4; ++m) { bf16_t* rowp = base + (size_t)(row0 + ai * 128 + m * 16) * 1024 + col0;
#pragma unroll
                for (int bj = 0; bj < 2; ++bj) { f32x4 v0 = acc[ai][bj][m][0], v1 = acc[ai][bj][m][1];
                    u32x4 w; w.x = pk2(v0[0], v0[1]); w.y = pk2(v0[2], v0[3]); w.z = pk2(v1[0], v1[1]); w.w = pk2(v1[2], v1[3]);
                    *(u32x4*)(rowp + bj * 128) = w; } }
    }
};
struct EpiInT {
    static constexpr bool PERM = true;
    bf16_t *vT, *vsT; float* sumsq;
    __device__ __forceinline__ void operator()(AccRef acc, const Unit& u, int wr, int wc, int fr, int fq) const {
        const bool isvs = u.pm >= 4;
        bf16_t* base = isvs ? vsT : vT;
        const int cs0 = (u.pm & 3) * 256 + wr * 64 + fr;
        const int j0 = wc * 32 + 8 * fq;
        float ss[2][8];
#pragma unroll
        for (int bj = 0; bj < 2; ++bj)
#pragma unroll
            for (int k = 0; k < 8; ++k) ss[bj][k] = 0.f;
#pragma unroll
        for (int ai = 0; ai < 2; ++ai)
#pragma unroll
            for (int m = 0; m < 4; ++m) { const int cs = cs0 + ai * 128 + m * 16;
#pragma unroll
                for (int bj = 0; bj < 2; ++bj) { f32x4 v0 = acc[ai][bj][m][0], v1 = acc[ai][bj][m][1];
                    if (isvs) {
#pragma unroll
                        for (int j = 0; j < 4; ++j) { v0[j] = gelu_tanh(v0[j]); v1[j] = gelu_tanh(v1[j]); ss[bj][j] += v0[j] * v0[j]; ss[bj][4 + j] += v1[j] * v1[j]; } }
                    u32x4 w; w.x = pk2(v0[0], v0[1]); w.y = pk2(v0[2], v0[3]); w.z = pk2(v1[0], v1[1]); w.w = pk2(v1[2], v1[3]);
                    const int bn = 2 * u.pn + bj;
                    *(u32x4*)(base + ((size_t)bn * 1024 + cs) * 128 + j0) = w; } }
        if (isvs) {
#pragma unroll
            for (int bj = 0; bj < 2; ++bj)
#pragma unroll
                for (int k = 0; k < 8; ++k) { float s = ss[bj][k]; s += __shfl_xor(s, 1); s += __shfl_xor(s, 2); s += __shfl_xor(s, 4); s += __shfl_xor(s, 8);
                    if (fr == 0) atomicAdd(sumsq + u.pn * 256 + bj * 128 + j0 + k, s); }
        }
    }
};
struct EpiPool {
    static constexpr bool PERM = true;
    bf16_t* y; const float* bias; const float* scale;
    __device__ __forceinline__ void operator()(AccRef acc, const Unit& u, int wr, int wc, int fr, int fq) const {
        const int row0 = u.pm * 256 + wr * 64 + fr, col0 = u.z * 256 + wc * 32 + 8 * fq;
#pragma unroll
        for (int bj = 0; bj < 2; ++bj) {
            const f32x4 b0 = *(const f32x4*)(bias + col0 + bj * 128), b1 = *(const f32x4*)(bias + col0 + bj * 128 + 4), s0 = *(const f32x4*)(scale + col0 + bj * 128), s1 = *(const f32x4*)(scale + col0 + bj * 128 + 4);
#pragma unroll
            for (int ai = 0; ai < 2; ++ai)
#pragma unroll
                for (int m = 0; m < 4; ++m) { bf16_t* rowp = y + (size_t)(row0 + ai * 128 + m * 16) * 1024 + col0;
                    const f32x4 v0 = (acc[ai][bj][m][0] + b0) * s0, v1 = (acc[ai][bj][m][1] + b1) * s1;
                    u32x4 w; w.x = pk2(v0[0], v0[1]); w.y = pk2(v0[2], v0[3]); w.z = pk2(v1[0], v1[1]); w.w = pk2(v1[2], v1[3]);
                    *(u32x4*)(rowp + bj * 128) = w; } }
    }
};
struct EpiBranch {
    static constexpr bool PERM = true;
    bf16_t* gcur; bf16_t* tmp; bf16_t* merged;
    __device__ __forceinline__ void operator()(AccRef acc, const Unit& u, int wr, int wc, int fr, int fq) const {
        const int row0 = u.pm * 256 + wr * 64 + fr, col0 = u.pn * 256 + wc * 32 + 8 * fq;
        const int z = u.z;
        if ((z & 1) == 0) {
#pragma unroll
            for (int ai = 0; ai < 2; ++ai)
#pragma unroll
                for (int m = 0; m < 4; ++m)
#pragma unroll
                    for (int bj = 0; bj < 2; ++bj) { f32x4 v0 = acc[ai][bj][m][0], v1 = acc[ai][bj][m][1];
                        const size_t o = (size_t)(row0 + ai * 128 + m * 16) * 1024 + col0 + bj * 128;
#pragma unroll
                        for (int j = 0; j < 4; ++j) { v0[j] = sigmoidf_(v0[j]); v1[j] = sigmoidf_(v1[j]); }
                        u32x4 w; w.x = pk2(v0[0], v0[1]); w.y = pk2(v0[2], v0[3]); w.z = pk2(v1[0], v1[1]); w.w = pk2(v1[2], v1[3]);
                        *(u32x4*)(gcur + o) = w; }
        } else {
            bf16_t* dst = (z == 5) ? merged : tmp;
#pragma unroll
            for (int ai = 0; ai < 2; ++ai) {
                u32x4 gw[4][2], tw[4][2];
#pragma unroll
                for (int m = 0; m < 4; ++m)
#pragma unroll
                    for (int bj = 0; bj < 2; ++bj) { const size_t o = (size_t)(row0 + ai * 128 + m * 16) * 1024 + col0 + bj * 128;
                        gw[m][bj] = *(const u32x4*)(gcur + o);
                        tw[m][bj] = (z != 1) ? *(const u32x4*)(tmp + o) : (u32x4){0u, 0u, 0u, 0u}; }
                asm volatile("" ::: "memory");
#pragma unroll
                for (int m = 0; m < 4; ++m)
#pragma unroll
                    for (int bj = 0; bj < 2; ++bj) { const size_t o = (size_t)(row0 + ai * 128 + m * 16) * 1024 + col0 + bj * 128;
                        const u32x4 g = gw[m][bj], t = tw[m][bj];
                        const f32x4 g0 = {bflo(g.x), bfhi(g.x), bflo(g.y), bfhi(g.y)}, g1 = {bflo(g.z), bfhi(g.z), bflo(g.w), bfhi(g.w)};
                        const f32x4 t0 = {bflo(t.x), bfhi(t.x), bflo(t.y), bfhi(t.y)}, t1 = {bflo(t.z), bfhi(t.z), bflo(t.w), bfhi(t.w)};
                        const f32x4 v0 = acc[ai][bj][m][0] * g0 + t0, v1 = acc[ai][bj][m][1] * g1 + t1;
                        u32x4 w; w.x = pk2(v0[0], v0[1]); w.y = pk2(v0[2], v0[3]); w.z = pk2(v1[0], v1[1]); w.w = pk2(v1[2], v1[3]);
                        *(u32x4*)(dst + o) = w; }
                asm volatile("" ::: "memory");
            }
        }
    }
};
struct EpiResid {
    static constexpr bool PERM = false;
    const float* xsrc; float* xdst; const float* gate;
    __device__ __forceinline__ void operator()(AccRef acc, const Unit& u, int wr, int wc, int fr, int fq) const {
        const int row0 = u.pm * 256 + wr * 64 + fr, col0 = u.pn * 256 + wc * 32 + 4 * fq;
        const float* gp = gate + (size_t)(u.pm >> 3) * 6144 + col0;
        f32x4 gv[2][2];
#pragma unroll
        for (int bj = 0; bj < 2; ++bj)
#pragma unroll
            for (int n = 0; n < 2; ++n) gv[bj][n] = *(const f32x4*)(gp + bj * 128 + n * 16);
#pragma unroll
        for (int ab = 0; ab < 4; ++ab) { const int ai = ab >> 1, m0 = (ab & 1) * 2;
            f32x4 xv[2][2][2];
#pragma unroll
            for (int mm = 0; mm < 2; ++mm)
#pragma unroll
                for (int bj = 0; bj < 2; ++bj)
#pragma unroll
                    for (int n = 0; n < 2; ++n) xv[mm][bj][n] = *(const f32x4*)(xsrc + (size_t)(row0 + ai * 128 + (m0 + mm) * 16) * 1024 + col0 + bj * 128 + n * 16);
            asm volatile("" ::: "memory");
#pragma unroll
            for (int mm = 0; mm < 2; ++mm)
#pragma unroll
                for (int bj = 0; bj < 2; ++bj)
#pragma unroll
                    for (int n = 0; n < 2; ++n) *(f32x4*)(xdst + (size_t)(row0 + ai * 128 + (m0 + mm) * 16) * 1024 + col0 + bj * 128 + n * 16) = xv[mm][bj][n] + gv[bj][n] * acc[ai][bj][m0 + mm][n];
            asm volatile("" ::: "memory");
        }
    }
};
struct EpiResidB {
    static constexpr bool PERM = true;
    const float* xf; const bf16_t* xb; bf16_t* xdst; const float* gate; int src_f32;
    __device__ __forceinline__ void operator()(AccRef acc, const Unit& u, int wr, int wc, int fr, int fq) const {
        const int row0 = u.pm * 256 + wr * 64 + fr, col0 = u.pn * 256 + wc * 32 + 8 * fq;
        const float* gp = gate + (size_t)(u.pm >> 3) * 6144 + col0;
        f32x4 gv[2][2];
#pragma unroll
        for (int bj = 0; bj < 2; ++bj)
#pragma unroll
            for (int n = 0; n < 2; ++n) gv[bj][n] = *(const f32x4*)(gp + bj * 128 + 4 * n);
#pragma unroll
        for (int ab = 0; ab < 4; ++ab) { const int ai = ab >> 1, m0 = (ab & 1) * 2;
            f32x4 x0[2][2], x1[2][2];
            if (src_f32) {
#pragma unroll
                for (int mm = 0; mm < 2; ++mm)
#pragma unroll
                    for (int bj = 0; bj < 2; ++bj) { const float* sp = xf + (size_t)(row0 + ai * 128 + (m0 + mm) * 16) * 1024 + col0 + bj * 128;
                        x0[mm][bj] = __builtin_nontemporal_load((const f32x4*)sp); x1[mm][bj] = __builtin_nontemporal_load((const f32x4*)(sp + 4)); }
            } else {
                u32x4 w[2][2];
#pragma unroll
                for (int mm = 0; mm < 2; ++mm)
#pragma unroll
                    for (int bj = 0; bj < 2; ++bj) w[mm][bj] = *(const u32x4*)(xb + (size_t)(row0 + ai * 128 + (m0 + mm) * 16) * 1024 + col0 + bj * 128);
#pragma unroll
                for (int mm = 0; mm < 2; ++mm)
#pragma unroll
                    for (int bj = 0; bj < 2; ++bj) { const u32x4 t = w[mm][bj];
                        x0[mm][bj] = (f32x4){bflo(t.x), bfhi(t.x), bflo(t.y), bfhi(t.y)}; x1[mm][bj] = (f32x4){bflo(t.z), bfhi(t.z), bflo(t.w), bfhi(t.w)}; }
            }
            asm volatile("" ::: "memory");
#pragma unroll
            for (int mm = 0; mm < 2; ++mm)
#pragma unroll
                for (int bj = 0; bj < 2; ++bj) { const f32x4 v0 = x0[mm][bj] + gv[bj][0] * acc[ai][bj][m0 + mm][0], v1 = x1[mm][bj] + gv[bj][1] * acc[ai][bj][m0 + mm][1];
                    u32x4 o; o.x = pk2(v0[0], v0[1]); o.y = pk2(v0[2], v0[3]); o.z = pk2(v1[0], v1[1]); o.w = pk2(v1[2], v1[3]);
                    *(u32x4*)(xdst + (size_t)(row0 + ai * 128 + (m0 + mm) * 16) * 1024 + col0 + bj * 128) = o; }
            asm volatile("" ::: "memory");
        }
    }
};
struct EpiFF1 {
    static constexpr bool PERM = true;
    bf16_t* hid;
    __device__ __forceinline__ void operator()(AccRef acc, const Unit& u, int wr, int wc, int fr, int fq) const {
        const int row0 = u.pm * 256 + wr * 64 + fr, col0 = u.pn * 256 + wc * 32 + 8 * fq;
#pragma unroll
        for (int ai = 0; ai < 2; ++ai)
#pragma unroll
            for (int m = 0; m < 4; ++m) { bf16_t* rowp = hid + (size_t)(row0 + ai * 128 + m * 16) * 4096 + col0;
#pragma unroll
                for (int bj = 0; bj < 2; ++bj) { f32x4 v0 = acc[ai][bj][m][0], v1 = acc[ai][bj][m][1];
#pragma unroll
                    for (int j = 0; j < 4; ++j) { const float a = fmaxf(v0[j], 0.f), b = fmaxf(v1[j], 0.f); v0[j] = a * a; v1[j] = b * b; }
                    u32x4 w; w.x = pk2(v0[0], v0[1]); w.y = pk2(v0[2], v0[3]); w.z = pk2(v1[0], v1[1]); w.w = pk2(v1[2], v1[3]);
                    *(u32x4*)(rowp + bj * 128) = w; } }
    }
};
struct BranchSched {
    pg8::StaticOrder so; const char *h, *wg, *slots, *wb;
    __device__ __forceinline__ bool next(int i, Unit& u) const {
        const int ti = i / 6, sub = i - ti * 6;
        if (!so.map(ti, u.pm, u.pn)) return false;
        u.z = sub; const int n = sub >> 1;
        if ((sub & 1) == 0) { u.a = h + (size_t)u.pm * (256 * 1024 * 2); u.b = wg + ((size_t)n * 1024 + (size_t)u.pn * 256) * 2048; }
        else { const char* y = slots + (size_t)((2 + n) & 3) * SLOT; u.a = y + (size_t)u.pm * (256 * 1024 * 2); u.b = wb + ((size_t)n * 1024 + (size_t)u.pn * 256) * 2048; }
        return true;
    }
    __device__ __forceinline__ void a_ready(const Unit&) const {}
    __device__ __forceinline__ void done(const Unit&) const {}
};
struct PoolSched {
    int G, c; const char *pooled, *wp;
    __device__ __forceinline__ bool next(int i, Unit& u) const {
        const int L = i * G + c; if (L >= 256) return false;
        u.pm = L & 63; u.z = L >> 6; u.pn = 0;
        u.a = pooled + (size_t)u.pm * (256 * 1024 * 2) + (size_t)u.z * 512; u.b = wp + (size_t)u.z * (256 * 256 * 2);
        return true;
    }
    __device__ __forceinline__ void a_ready(const Unit&) const {}
    __device__ __forceinline__ void done(const Unit&) const {}
};

__device__ __forceinline__ int winmap(int n0) {
    if (n0 < 1024) return n0;
    if (n0 < 2048) return 4096 + (n0 - 1024);
    if (n0 < 4096) return 1024 + (n0 - 2048);
    if (n0 < 5120) return 5120 + (n0 - 4096);
    if (n0 < 6144) return 3072 + (n0 - 5120);
    return n0;
}
template <bool WINMAP>
__device__ __forceinline__ void conv_item(const float* W, int K, int N, bf16_t* WT, int item, float* scr, int lane) {
    const int nblk = N / 32, kb = item / nblk, nb = item - kb * nblk, k0 = 64 * kb, n0 = 32 * nb;
    const int r0 = WINMAP ? winmap(n0) : n0;
    float wv[32];
#pragma unroll
    for (int i = 0; i < 32; ++i) { const int kk = 2 * i + (lane >> 5); wv[i] = __builtin_nontemporal_load(&W[(size_t)(k0 + kk) * N + n0 + (lane & 31)]); }
#pragma unroll
    for (int i = 0; i < 32; ++i) { const int kk = 2 * i + (lane >> 5); scr[kk * 33 + (lane & 31)] = wv[i]; }
    if (false)
    for (int i = 0; i < 32; ++i) { const int kk = 2 * i + (lane >> 5); scr[kk * 33 + (lane & 31)] = __builtin_nontemporal_load(&W[(size_t)(k0 + kk) * N + n0 + (lane & 31)]); }
    LDS_WAIT();
    const int c = lane & 7;
#pragma unroll
    for (int j = 0; j < 4; ++j) { const int n = (lane >> 3) + 8 * j; const float* s = scr + (8 * c) * 33 + n;
        u32x4 o; o.x = pk2(s[0 * 33], s[1 * 33]); o.y = pk2(s[2 * 33], s[3 * 33]); o.z = pk2(s[4 * 33], s[5 * 33]); o.w = pk2(s[6 * 33], s[7 * 33]);
        *(u32x4*)(WT + (size_t)(r0 + n) * K + k0 + 8 * c) = o; }
    LDS_WAIT();
}
__device__ __forceinline__ void conv_set(const Params& p, int l, int set, unsigned char* lds, int gw, int ngw, int wave, int lane) {
    float* scr = (float*)(lds + wave * 8704);
    if (set == 0) {
        for (int it = gw; it < 4608 + 128; it += ngw) {
            if (it < 4608) conv_item<true>(p.w_in + (size_t)l * DM * DIN, 1024, DIN, (bf16_t*)(p.ws + OFF_WIN), it, scr, lane);
            else { const int r = it - 4608, g = r >> 5; conv_item<false>(p.w_pool + ((size_t)l * 4 + g) * 65536, 256, 256, (bf16_t*)(p.ws + OFF_WPOOL) + (size_t)g * 65536, r & 31, scr, lane); }
        }
    } else if (set == 1) {
        for (int it = gw; it < 2048; it += ngw) {
            if (it < 1536) { const int n = it >> 9; conv_item<false>(p.w_branch + ((size_t)l * 3 + n) * 1048576, 1024, 1024, (bf16_t*)(p.ws + OFF_WBR) + (size_t)n * 1048576, it & 511, scr, lane); }
            else conv_item<false>(p.w_out + (size_t)l * 1048576, 1024, 1024, (bf16_t*)(p.ws + OFF_WOUT), it - 1536, scr, lane);
        }
    } else {
        for (int it = gw; it < 4096; it += ngw) {
            if (it < 2048) conv_item<false>(p.w_ff1 + (size_t)l * 4194304, 1024, 4096, (bf16_t*)(p.ws + OFF_WFF1), it, scr, lane);
            else conv_item<false>(p.w_ff2 + (size_t)l * 4194304, 4096, 1024, (bf16_t*)(p.ws + OFF_WFF2), it - 2048, scr, lane);
        }
    }
}

__device__ __forceinline__ void norm_rows(const float* xsrc, bf16_t* hdst, const float* gain, const float* modl  , int gw, int ngw, int lane) {
    for (int row = gw; row < MTOK; row += ngw) {
        const int b = row >> 11;
        const f32x4* xr = (const f32x4*)(xsrc + (size_t)row * 1024) + lane;
        f32x4 v[4]; float s = 0.f;
#pragma unroll
        for (int j = 0; j < 4; ++j) { v[j] = xr[64 * j]; s += (v[j].x * v[j].x + v[j].y * v[j].y) + (v[j].z * v[j].z + v[j].w * v[j].w); }
        const float rstd = rsqrtf(wave_sum(s) * (1.f / 1024.f) + EPS);
        const float* sh = modl + (size_t)b * 6144; const float* sc = sh + 1024;
        u32x2* o8 = (u32x2*)(hdst + (size_t)row * 1024) + lane;
        f32x4 ga[4], ca[4], ha[4];
#pragma unroll
        for (int j = 0; j < 4; ++j) { const int col = (lane + 64 * j) * 4; ga[j] = *(const f32x4*)(gain + col); ca[j] = *(const f32x4*)(sc + col); ha[j] = *(const f32x4*)(sh + col); }
#pragma unroll
        for (int j = 0; j < 4; ++j) {
            const f32x4 g = ga[j], c4 = ca[j], h4 = ha[j];
            const f32x4 y = v[j] * rstd * g * (c4 + 1.0f) + h4;
            u32x2 w; w.x = pk2(y.x, y.y); w.y = pk2(y.z, y.w); o8[64 * j] = w; }
    }
}

__device__ __forceinline__ void norm_rows_b(const bf16_t* xsrc, bf16_t* hdst, const float* gain, const float* modl, int gw, int ngw, int lane) {
    for (int row = gw; row < MTOK; row += ngw) {
        const int b = row >> 11;
        const u32x4* xr = (const u32x4*)(xsrc + (size_t)row * 1024) + lane;
        float v[2][8]; float s = 0.f;
#pragma unroll
        for (int j = 0; j < 2; ++j) { const u32x4 t = xr[64 * j];
            v[j][0] = bflo(t.x); v[j][1] = bfhi(t.x); v[j][2] = bflo(t.y); v[j][3] = bfhi(t.y); v[j][4] = bflo(t.z); v[j][5] = bfhi(t.z); v[j][6] = bflo(t.w); v[j][7] = bfhi(t.w);
#pragma unroll
            for (int k = 0; k < 8; ++k) s += v[j][k] * v[j][k]; }
        const float rstd = rsqrtf(wave_sum(s) * (1.f / 1024.f) + EPS);
        const float* sh = modl + (size_t)b * 6144; const float* sc = sh + 1024;
        u32x4* o16 = (u32x4*)(hdst + (size_t)row * 1024) + lane;
        f32x4 ga[2][2], ca[2][2], ha[2][2];
#pragma unroll
        for (int j = 0; j < 2; ++j)
#pragma unroll
            for (int q = 0; q < 2; ++q) { const int col = (lane + 64 * j) * 8 + 4 * q; ga[j][q] = *(const f32x4*)(gain + col); ca[j][q] = *(const f32x4*)(sc + col); ha[j][q] = *(const f32x4*)(sh + col); }
#pragma unroll
        for (int j = 0; j < 2; ++j) {
            const f32x4 y0 = (f32x4){v[j][0], v[j][1], v[j][2], v[j][3]} * rstd * ga[j][0] * (ca[j][0] + 1.0f) + ha[j][0];
            const f32x4 y1 = (f32x4){v[j][4], v[j][5], v[j][6], v[j][7]} * rstd * ga[j][1] * (ca[j][1] + 1.0f) + ha[j][1];
            u32x4 w; w.x = pk2(y0.x, y0.y); w.y = pk2(y0.z, y0.w); w.z = pk2(y1.x, y1.y); w.w = pk2(y1.z, y1.w); o16[64 * j] = w; }
    }
}

#define KVBASE(p) ((bf16_t*)(p).out + (size_t)MTOK * DM)
constexpr int LROW = 272;
__device__ __forceinline__ bf16x8 asbf(u32x4 v) { return __builtin_bit_cast(bf16x8, v); }
__device__ __forceinline__ f32x4 mfma16(bf16x8 a, bf16x8 b, f32x4 c) { return __builtin_amdgcn_mfma_f32_16x16x32_bf16(a, b, c, 0, 0, 0); }
__device__ __forceinline__ void stage_rows128(unsigned char* dst, const bf16_t* src, int nrows, int tid) {
    (void)nrows;
#pragma unroll
    for (int hb = 0; hb < 2; ++hb) {
        u32x4 v[4];
#pragma unroll
        for (int i = 0; i < 4; ++i) { const int ci = tid + (hb * 4 + i) * 512; v[i] = *(const u32x4*)(src + (size_t)(ci >> 4) * 128 + (ci & 15) * 8); }
#pragma unroll
        for (int i = 0; i < 4; ++i) { const int ci = tid + (hb * 4 + i) * 512; *(u32x4*)(dst + (ci >> 4) * LROW + (ci & 15) * 16) = v[i]; }
    }
}
__device__ __forceinline__ float inv_freq(int f) { return exp2f(-(float)f * (13.287712379549449f / 64.0f)); }
__device__ __forceinline__ void rot8(u32x4 lo, u32x4 hi, float pos, int f0, float scale, u32x4& olo, u32x4& ohi) {
    float a[8], b[8];
    a[0] = bflo(lo.x); a[1] = bfhi(lo.x); a[2] = bflo(lo.y); a[3] = bfhi(lo.y); a[4] = bflo(lo.z); a[5] = bfhi(lo.z); a[6] = bflo(lo.w); a[7] = bfhi(lo.w);
    b[0] = bflo(hi.x); b[1] = bfhi(hi.x); b[2] = bflo(hi.y); b[3] = bfhi(hi.y); b[4] = bflo(hi.z); b[5] = bfhi(hi.z); b[6] = bflo(hi.w); b[7] = bfhi(hi.w);
    float o1[8], o2[8];
#pragma unroll
    for (int i = 0; i < 8; ++i) { float s, c;
#ifdef NOSINCOS
        s = 0.f; c = 1.f; (void)pos;
#else
        { const float ang = pos * inv_freq(f0 + i); s = __sinf(ang); c = __cosf(ang); }
#endif
 o1[i] = (a[i] * c - b[i] * s) * scale; o2[i] = (b[i] * c + a[i] * s) * scale; }
    olo.x = pk2(o1[0], o1[1]); olo.y = pk2(o1[2], o1[3]); olo.z = pk2(o1[4], o1[5]); olo.w = pk2(o1[6], o1[7]);
    ohi.x = pk2(o2[0], o2[1]); ohi.y = pk2(o2[2], o2[3]); ohi.z = pk2(o2[4], o2[5]); ohi.w = pk2(o2[6], o2[7]);
}
__device__ __forceinline__ float log_gamma(int h) { return log1pf(-exp2f(-5.0f - (float)h)); }

__device__ __forceinline__ void sgu_item(const Params& p, int l, int bn, int g, unsigned char* lds, int tid, int wave, int lane) {
    const int r = lane & 15, q4 = lane >> 4;
    const bf16_t* vsT = (const bf16_t*)(p.ws + SLOTP(6)) + ((size_t)bn * 1024 + g * 256) * 128;
    bf16_t* ubuf = (bf16_t*)(p.ws + SLOTP(3));
    const float* sumsq = (const float*)(p.ws + OFF_SUMSQ) + bn * 128;
    float* rs = (float*)(lds + 256 * LROW);
    __syncthreads();
    stage_rows128(lds, vsT, 256, tid);
    if (tid < 128) rs[tid] = rsqrtf(sumsq[tid] * (1.f / 1024.f) + EPS);
    __syncthreads();
    const int t = wave * 16 + r;
    const int nkk = (wave >> 1) + 1;
    const float* Wrow = p.ws_gmlp + (((size_t)l * 4 + g) * 128 + t) * 128;
    f32x4 acc[16];
#pragma unroll
    for (int i = 0; i < 16; ++i) acc[i] = (f32x4){0.f, 0.f, 0.f, 0.f};
    for (int kk = 0; kk < nkk; ++kk) {
        const int s0 = kk * 32 + q4 * 8;
        const f32x4 w0 = *(const f32x4*)(Wrow + s0), w1 = *(const f32x4*)(Wrow + s0 + 4);
        float wv[8] = {w0.x, w0.y, w0.z, w0.w, w1.x, w1.y, w1.z, w1.w};
#pragma unroll
        for (int i = 0; i < 8; ++i) wv[i] = (s0 + i <= t) ? wv[i] * rs[s0 + i] : 0.f;
        u32x4 aw; aw.x = pk2(wv[0], wv[1]); aw.y = pk2(wv[2], wv[3]); aw.z = pk2(wv[4], wv[5]); aw.w = pk2(wv[6], wv[7]);
        const bf16x8 af = asbf(aw);
#pragma unroll
        for (int nt = 0; nt < 16; ++nt) { const bf16x8 bfr = asbf(*(const u32x4*)(lds + (nt * 16 + r) * LROW + s0 * 2)); acc[nt] = mfma16(bfr, af, acc[nt]); }
    }
    const int tok = bn * 128 + t;
    const float bt = p.bs_gmlp[((size_t)l * 4 + g) * 128 + t];
    const float* gain = p.vnorm + (size_t)l * 1024 + g * 256;
    bf16_t* up = ubuf + (size_t)tok * 1024 + g * 256;
    u32x2 uall[16]; f32x4 gall[16];
#pragma unroll
    for (int nt = 0; nt < 16; ++nt) { const int c = nt * 16 + q4 * 4; uall[nt] = *(const u32x2*)(up + c); gall[nt] = *(const f32x4*)(gain + c); }
    asm volatile("" ::: "memory");
#pragma unroll
    for (int nt = 0; nt < 16; ++nt) { const int c = nt * 16 + q4 * 4;
        const f32x4 gn = gall[nt];
        const u32x2 uw = uall[nt];
        const float y0 = gelu_tanh(bflo(uw.x)) * (acc[nt][0] * gn.x + bt), y1 = gelu_tanh(bfhi(uw.x)) * (acc[nt][1] * gn.y + bt), y2 = gelu_tanh(bflo(uw.y)) * (acc[nt][2] * gn.z + bt), y3 = gelu_tanh(bfhi(uw.y)) * (acc[nt][3] * gn.w + bt);
        u32x2 o; o.x = pk2(y0, y1); o.y = pk2(y2, y3); *(u32x2*)(up + c) = o; }
}

__device__ __forceinline__ void kv_item(const Params& p, int bnh, unsigned char* lds, int tid, int wave, int lane, int dslot = 6) {
    const int r = lane & 15, q4 = lane >> 4;
    const int h = bnh & 3, bn = bnh >> 2;
    const bf16_t* qk = (const bf16_t*)(p.ws + SLOTP(1));
    const bf16_t* vT = (const bf16_t*)(p.ws + SLOTP(4)) + ((size_t)bn * 1024 + h * 256) * 128;
    (void)dslot; bf16_t* kvT = KVBASE(p) + (size_t)bnh * 32768;
    const float lg = log_gamma(h);
    __syncthreads();
    { const int j0 = (tid & 63) * 2, f0 = (tid >> 6) * 8;
      const int tok = bn * 128 + j0;
      const bf16_t* kp = qk + (size_t)tok * 1024 + 512 + h * 128 + f0;
      const u32x4 lo0 = *(const u32x4*)kp, hi0 = *(const u32x4*)(kp + 64), lo1 = *(const u32x4*)(kp + 1024), hi1 = *(const u32x4*)(kp + 1024 + 64);
      const float sc0 = 0.08838834764831845f * __expf(lg * (float)(127 - j0)), sc1 = 0.08838834764831845f * __expf(lg * (float)(126 - j0));
      u32x4 a0, b0, a1, b1; rot8(lo0, hi0, (float)p.pos[tok], f0, sc0, a0, b0); rot8(lo1, hi1, (float)p.pos[tok + 1], f0, sc1, a1, b1);
      const unsigned A0[4] = {a0.x, a0.y, a0.z, a0.w}, B0[4] = {b0.x, b0.y, b0.z, b0.w}, A1[4] = {a1.x, a1.y, a1.z, a1.w}, B1[4] = {b1.x, b1.y, b1.z, b1.w};
      unsigned* d0 = (unsigned*)(lds + f0 * LROW + j0 * 2); unsigned* d1 = (unsigned*)(lds + (64 + f0) * LROW + j0 * 2);
#pragma unroll
      for (int i = 0; i < 4; ++i) {
          d0[(2 * i) * (LROW / 4)] = (A0[i] & 0xffffu) | (A1[i] << 16); d0[(2 * i + 1) * (LROW / 4)] = (A0[i] >> 16) | (A1[i] & 0xffff0000u);
          d1[(2 * i) * (LROW / 4)] = (B0[i] & 0xffffu) | (B1[i] << 16); d1[(2 * i + 1) * (LROW / 4)] = (B0[i] >> 16) | (B1[i] & 0xffff0000u); }
    }
    bf16x8 af[2][4];
#pragma unroll
    for (int mt = 0; mt < 2; ++mt)
#pragma unroll
        for (int kk = 0; kk < 4; ++kk) af[mt][kk] = asbf(*(const u32x4*)(vT + (size_t)(wave * 32 + mt * 16 + r) * 128 + kk * 32 + q4 * 8));
    __syncthreads();
#ifdef KVDUMP
    { const u32x4* src = (const u32x4*)(lds + tid * 64); u32x4* dst = (u32x4*)(kvT + tid * 32);
      dst[0] = src[0]; dst[1] = src[1]; dst[2] = src[2]; dst[3] = src[3];
      u32x4* dst2 = (u32x4*)(kvT + 16384 + tid * 32);
      dst2[0] = __builtin_bit_cast(u32x4, af[0][0]); dst2[1] = __builtin_bit_cast(u32x4, af[0][1]); dst2[2] = __builtin_bit_cast(u32x4, af[1][2]); dst2[3] = __builtin_bit_cast(u32x4, af[1][3]); return; }
#endif
    f32x4 acc[2][8];
#pragma unroll
    for (int mt = 0; mt < 2; ++mt)
#pragma unroll
        for (int nt = 0; nt < 8; ++nt) acc[mt][nt] = (f32x4){0.f, 0.f, 0.f, 0.f};
#pragma unroll
    for (int kk = 0; kk < 4; ++kk)
#pragma unroll
        for (int nt = 0; nt < 8; ++nt) { const bf16x8 bfr = asbf(*(const u32x4*)(lds + (nt * 16 + r) * LROW + (kk * 32 + q4 * 8) * 2));
            acc[0][nt] = mfma16(bfr, af[0][kk], acc[0][nt]); acc[1][nt] = mfma16(bfr, af[1][kk], acc[1][nt]); }
#pragma unroll
    for (int mt = 0; mt < 2; ++mt)
#pragma unroll
        for (int nt = 0; nt < 8; ++nt) { u32x2 o; o.x = pk2(acc[mt][nt][0], acc[mt][nt][1]); o.y = pk2(acc[mt][nt][2], acc[mt][nt][3]);
            *(u32x2*)(kvT + (size_t)(wave * 32 + mt * 16 + r) * 128 + nt * 16 + q4 * 4) = o; }
}

__device__ __forceinline__ void ret_item(const Params& p, int bnh, unsigned char* lds, int tid, int wave, int lane) {
    const int r = lane & 15, q4 = lane >> 4;
    const int h = bnh & 3, bn = bnh >> 2;
    const bf16_t* qk = (const bf16_t*)(p.ws + SLOTP(1));
    const bf16_t* vT = (const bf16_t*)(p.ws + SLOTP(4)) + ((size_t)bn * 1024 + h * 256) * 128;
    const bf16_t* prevT = KVBASE(p) + (size_t)bnh * 32768;
    bf16_t* gbuf = (bf16_t*)(p.ws + SLOTP(2));
    unsigned char* ldsK = lds; unsigned char* ldsV = lds + 128 * LROW;
    const float lg = log_gamma(h);
    __syncthreads();
    stage_rows128(ldsV, prevT, 256, tid);
    __builtin_amdgcn_sched_barrier(0);
#pragma unroll
    for (int ps = 0; ps < 2; ++ps) { const int t = ps * 512 + tid, cgi = t & 7, j = t >> 3, f0 = cgi * 8;
        const int tok = bn * 128 + j;
        const bf16_t* kp = qk + (size_t)tok * 1024 + 512 + h * 128 + f0;
        const u32x4 lo = *(const u32x4*)kp, hi = *(const u32x4*)(kp + 64);
        u32x4 olo, ohi; rot8(lo, hi, (float)p.pos[tok], f0, 0.08838834764831845f, olo, ohi);
        *(u32x4*)(ldsK + j * LROW + f0 * 2) = olo; *(u32x4*)(ldsK + j * LROW + (64 + f0) * 2) = ohi; }
    __builtin_amdgcn_sched_barrier(0);
    const int irow = wave * 16 + r, tokq = bn * 128 + irow;
    bf16x8 qf[4];
    { const bf16_t* qp = qk + (size_t)tokq * 1024 + h * 128 + q4 * 8;
      const u32x4 q0 = *(const u32x4*)qp, q1 = *(const u32x4*)(qp + 32), q2 = *(const u32x4*)(qp + 64), q3 = *(const u32x4*)(qp + 96);
      const float ps = (float)p.pos[tokq];
      u32x4 o0, o1, o2, o3; rot8(q0, q2, ps, q4 * 8, 1.0f, o0, o2); rot8(q1, q3, ps, 32 + q4 * 8, 1.0f, o1, o3);
      qf[0] = asbf(o0); qf[1] = asbf(o1); qf[2] = asbf(o2); qf[3] = asbf(o3); }
    __syncthreads();
    const int nkk2 = (wave >> 1) + 1;
    bf16x8 pf[4];
#pragma unroll
    for (int kk2 = 0; kk2 < 4; ++kk2) {
        u32x4 pw = {0u, 0u, 0u, 0u};
        if (kk2 < nkk2) {
#pragma unroll
            for (int hh = 0; hh < 2; ++hh) { const int nt = kk2 * 2 + hh;
                f32x4 s = {0.f, 0.f, 0.f, 0.f};
#pragma unroll
                for (int kk = 0; kk < 4; ++kk) { const bf16x8 kf = asbf(*(const u32x4*)(ldsK + (nt * 16 + r) * LROW + (kk * 32 + q4 * 8) * 2)); s = mfma16(kf, qf[kk], s); }
                float pv[4];
#pragma unroll
                for (int i = 0; i < 4; ++i) { const int j = nt * 16 + q4 * 4 + i; const int dlt = irow - j; pv[i] = dlt >= 0 ? s[i] * __expf(lg * (float)dlt) : 0.f; }
                if (hh == 0) { pw.x = pk2(pv[0], pv[1]); pw.y = pk2(pv[2], pv[3]); } else { pw.z = pk2(pv[0], pv[1]); pw.w = pk2(pv[2], pv[3]); } }
        }
        pf[kk2] = asbf(pw);
        __builtin_amdgcn_sched_barrier(0);
    }
    f32x4 acc[16];
#pragma unroll
    for (int i = 0; i < 16; ++i) acc[i] = (f32x4){0.f, 0.f, 0.f, 0.f};
    if ((bn & 15) != 0) {
#pragma unroll
        for (int kk = 0; kk < 4; ++kk) {
#pragma unroll
            for (int nt = 0; nt < 16; ++nt) { const bf16x8 bfr = asbf(*(const u32x4*)(ldsV + (nt * 16 + r) * LROW + (kk * 32 + q4 * 8) * 2)); acc[nt] = mfma16(bfr, qf[kk], acc[nt]); }
            __builtin_amdgcn_sched_barrier(0); }
        const float dq = __expf(lg * (float)(irow + 1));
#pragma unroll
        for (int nt = 0; nt < 16; ++nt) acc[nt] = acc[nt] * dq;
    }
    __syncthreads();
    stage_rows128(ldsV, vT, 256, tid);
    __syncthreads();
    for (int kk2 = 0; kk2 < nkk2; ++kk2) {
        const bf16x8 pa = kk2 == 0 ? pf[0] : (kk2 == 1 ? pf[1] : (kk2 == 2 ? pf[2] : pf[3]));
#pragma unroll
        for (int nt = 0; nt < 16; ++nt) { const unsigned char* vp = ldsV + (nt * 16 + r) * LROW + (kk2 * 32 + q4 * 4) * 2;
            const u32x2 v0 = *(const u32x2*)vp, v1 = *(const u32x2*)(vp + 32);
            u32x4 vv; vv.x = v0.x; vv.y = v0.y; vv.z = v1.x; vv.w = v1.y;
            acc[nt] = mfma16(asbf(vv), pa, acc[nt]); }
    }
    float ss = 0.f;
#pragma unroll
    for (int nt = 0; nt < 16; ++nt) ss += (acc[nt][0] * acc[nt][0] + acc[nt][1] * acc[nt][1]) + (acc[nt][2] * acc[nt][2] + acc[nt][3] * acc[nt][3]);
    ss += __shfl_xor(ss, 16); ss += __shfl_xor(ss, 32);
    const float rstd = rsqrtf(ss * (1.f / 256.f) + EPS);
    bf16_t* gp = gbuf + (size_t)tokq * 1024 + h * 256 + q4 * 4;
    u32x2 gall[16];
#pragma unroll
    for (int nt = 0; nt < 16; ++nt) gall[nt] = *(const u32x2*)(gp + nt * 16);
    asm volatile("" ::: "memory");
#pragma unroll
    for (int nt = 0; nt < 16; ++nt) { const u32x2 gw = gall[nt];
        u32x2 o; o.x = pk2(siluf_(bflo(gw.x)) * acc[nt][0] * rstd, siluf_(bfhi(gw.x)) * acc[nt][1] * rstd); o.y = pk2(siluf_(bflo(gw.y)) * acc[nt][2] * rstd, siluf_(bfhi(gw.y)) * acc[nt][3] * rstd);
        *(u32x2*)(gp + nt * 16) = o; }
}

template <int W>
__device__ __forceinline__ void pooled_task(const bf16_t* pb, bf16_t* ob, int cgi, int seg) {
    const int row0 = seg * 16, s0 = row0 & (SEQ - 1);
    const bf16_t* base = pb + (size_t)row0 * 1024 + cgi * 8;
    u32x4 R[W - 1 + 16];
#pragma unroll
    for (int i = 0; i < W - 1 + 16; ++i) { const int rel = i - (W - 1);
        R[i] = (s0 + rel >= 0) ? *(const u32x4*)(base + (ptrdiff_t)rel * 1024) : (u32x4){0u, 0u, 0u, 0u}; }
    float S[8];
#pragma unroll
    for (int k = 0; k < 8; ++k) S[k] = 0.f;
#pragma unroll
    for (int i = 0; i < W - 1; ++i) { const u32x4 v = R[i];
        S[0] += bflo(v.x); S[1] += bfhi(v.x); S[2] += bflo(v.y); S[3] += bfhi(v.y); S[4] += bflo(v.z); S[5] += bfhi(v.z); S[6] += bflo(v.w); S[7] += bfhi(v.w); }
#pragma unroll
    for (int t = 0; t < 16; ++t) {
        const int s = s0 + t;
        const u32x4 v = R[W - 1 + t];
        const float c[8] = {bflo(v.x), bfhi(v.x), bflo(v.y), bfhi(v.y), bflo(v.z), bfhi(v.z), bflo(v.w), bfhi(v.w)};
        const float inv = 1.0f / (float)min(s + 1, W);
        float o[8];
#pragma unroll
        for (int k = 0; k < 8; ++k) { S[k] += c[k]; o[k] = S[k] * inv - c[k]; }
        u32x4 ow; ow.x = pk2(o[0], o[1]); ow.y = pk2(o[2], o[3]); ow.z = pk2(o[4], o[5]); ow.w = pk2(o[6], o[7]);
        *(u32x4*)(ob + (size_t)(row0 + t) * 1024 + cgi * 8) = ow;
        const u32x4 x = R[t];
        S[0] -= bflo(x.x); S[1] -= bfhi(x.x); S[2] -= bflo(x.y); S[3] -= bfhi(x.y); S[4] -= bflo(x.z); S[5] -= bfhi(x.z); S[6] -= bflo(x.w); S[7] -= bfhi(x.w);
    }
}
__device__ __forceinline__ void pooled_tasks(const Params& p, int gtid, int nthr) {
    const bf16_t* pb = (const bf16_t*)(p.ws + SLOTP(5));
    bf16_t* ob = (bf16_t*)(p.ws + SLOTP(0));
    for (int task = gtid; task < 131072; task += nthr) {
        const int g = (task >> 6) & 3, cgi = g * 32 + (task & 31), seg = ((task >> 8) << 1) | ((task >> 5) & 1);
        if (g == 0) pooled_task<2>(pb, ob, cgi, seg); else if (g == 1) pooled_task<4>(pb, ob, cgi, seg); else if (g == 2) pooled_task<8>(pb, ob, cgi, seg); else pooled_task<16>(pb, ob, cgi, seg);
    }
}
__device__ __forceinline__ void scan_tasks(const Params& p, int gtid, int nthr) {
    bf16_t* kv = KVBASE(p);
    for (int task = gtid; task < 131072; task += nthr) {
        const int o = task & 4095, bh = task >> 12, b = bh >> 2, h = bh & 3;
        const float dc = __expf(log_gamma(h) * 128.0f);
        float st[8];
#pragma unroll
        for (int i = 0; i < 8; ++i) st[i] = 0.f;
        u32x4 v[16];
#pragma unroll
        for (int n = 0; n < 16; ++n) v[n] = *(const u32x4*)(kv + ((size_t)((b * 16 + n) * 4 + h)) * 32768 + o * 8);
#pragma unroll
        for (int n = 0; n < 16; ++n) {
            u32x4 ow; ow.x = pk2(st[0], st[1]); ow.y = pk2(st[2], st[3]); ow.z = pk2(st[4], st[5]); ow.w = pk2(st[6], st[7]);
            *(u32x4*)(kv + ((size_t)((b * 16 + n) * 4 + h)) * 32768 + o * 8) = ow;
            const float c[8] = {bflo(v[n].x), bfhi(v[n].x), bflo(v[n].y), bfhi(v[n].y), bflo(v[n].z), bfhi(v[n].z), bflo(v[n].w), bfhi(v[n].w)};
#pragma unroll
            for (int i = 0; i < 8; ++i) st[i] = dc * st[i] + c[i];
        }
    }
}


#define XB_TMO      128
#define XB_XCNT(j)  (256  + 64 * (j))
#define XB_XSUB(j)  (1280 + 64 * (j))
#define XB_XGEN(j)  (2304 + 64 * (j))
#define XB_TOP      3328
#define XB_TOPGEN   3392
#define XCD_BAR_WORDS 3456
#define XB_SPIN_CAP (1u << 18)
__device__ __forceinline__ unsigned xb_ld(unsigned* p)              { return __hip_atomic_load(p, __ATOMIC_RELAXED, __HIP_MEMORY_SCOPE_AGENT); }
__device__ __forceinline__ unsigned xb_add(unsigned* p, unsigned v) { return __hip_atomic_fetch_add(p, v, __ATOMIC_RELAXED, __HIP_MEMORY_SCOPE_AGENT); }
__device__ __forceinline__ unsigned xb_xcc_id() { return (unsigned)__builtin_amdgcn_s_getreg((3 << 11) | 20) & 0xFu; }
#define XB_SPIN(cond, bar) do { unsigned _sp = 0; while (cond) { __builtin_amdgcn_s_sleep(1); \
    if ((++_sp & 255u) == 0u) { if (xb_ld(&(bar)[XB_TMO])) break; if (_sp > XB_SPIN_CAP) { atomicAdd(&(bar)[XB_TMO], 1u); break; } } } } while (0)
struct XcdBarrier { unsigned* bar; unsigned x; volatile LAS unsigned* st; };
__device__ __forceinline__ void xcd_barrier_complete(unsigned* bar, unsigned x, unsigned& nloc, unsigned& nx) {
    const unsigned G = gridDim.x * gridDim.y * gridDim.z;
    unsigned sum, cnt, mine, sp = 0u;
    for (;;) {
        sum = 0u; cnt = 0u; mine = 0u;
#pragma unroll
        for (unsigned j = 0; j < 16; ++j) { const unsigned c = xb_ld(&bar[XB_XCNT(j)]); sum += c; cnt += (c > 0u) ? 1u : 0u; mine = (j == x) ? c : mine; }
        if (sum == G) break;
        __builtin_amdgcn_s_sleep(1);
        if ((++sp & 255u) == 0u) { if (xb_ld(&bar[XB_TMO])) break; if (sp > XB_SPIN_CAP) { atomicAdd(&bar[XB_TMO], 1u); break; } }
    }
    nloc = mine > 0u ? mine : 1u; nx = cnt > 0u ? cnt : 1u;
}
__device__ __forceinline__ void xcd_barrier(const XcdBarrier& b) {
    asm volatile("s_waitcnt vmcnt(0)" ::: "memory");
    __syncthreads();
    if (threadIdx.x == 0) {
        unsigned* bar = b.bar;
        __builtin_amdgcn_s_waitcnt(0);
        unsigned nloc = b.st[0], nx = b.st[1];
        if (nloc == 0u) { xcd_barrier_complete(bar, b.x, nloc, nx); b.st[0] = nloc; b.st[1] = nx; }
        const unsigned old = xb_add(&bar[XB_XSUB(b.x)], 1u);
        const unsigned gen = old / nloc;
        if (old + 1u == (gen + 1u) * nloc) {
            __builtin_amdgcn_fence(__ATOMIC_RELEASE, "agent");
            asm volatile("s_waitcnt vmcnt(0)" ::: "memory");
            const unsigned og = xb_add(&bar[XB_TOP], 1u);
            const unsigned tg = og / nx;
            if (og + 1u == (tg + 1u) * nx) xb_add(&bar[XB_TOPGEN], 1u);
            else XB_SPIN(xb_ld(&bar[XB_TOPGEN]) == tg, bar);
            __builtin_amdgcn_fence(__ATOMIC_ACQUIRE, "agent");
            xb_add(&bar[XB_XGEN(b.x)], 1u);
            asm volatile("s_waitcnt vmcnt(0)" ::: "memory");
        } else {
            XB_SPIN(xb_ld(&bar[XB_XGEN(b.x)]) == gen, bar);
            __builtin_amdgcn_fence(__ATOMIC_ACQUIRE, "agent");
            asm volatile("s_waitcnt vmcnt(0)" ::: "memory");
        }
    }
    __syncthreads();
}
__device__ __forceinline__ void gsync(cg::grid_group& g) {
    asm volatile("s_waitcnt vmcnt(0)" ::: "memory");
    __syncthreads();
    if (threadIdx.x < 64) { __builtin_amdgcn_fence(__ATOMIC_RELEASE, "agent"); asm volatile("s_waitcnt vmcnt(0)" ::: "memory"); }
    g.sync();
    if (threadIdx.x < 64) { __builtin_amdgcn_fence(__ATOMIC_ACQUIRE, "agent"); asm volatile("s_waitcnt vmcnt(0)" ::: "memory"); }
    __syncthreads();
}
#ifndef SKIPMASK
#define SKIPMASK 0
#endif
#define PH(n) if (!((SKIPMASK >> (n)) & 1) && ph >= ph_lo && ph < ph_hi)
__global__ void __launch_bounds__(512, 2) fwd_megakernel(Params pk_unused) {
    extern __shared__ __attribute__((aligned(16))) unsigned char shm[];
    cg::grid_group grid = cg::this_grid();
    LAS unsigned char* ldsl = (LAS unsigned char*)shm;
    typedef const __attribute__((address_space(4))) Params* KArgP;
    int ph = 0; const int ph_lo = pk_unused.ph_lo, ph_hi = pk_unused.ph_hi;
    volatile LAS unsigned* xst = (volatile LAS unsigned*)(ldsl + 131072);
    if (threadIdx.x == 0) { xst[0] = 0u; xst[1] = 0u; }
    __syncthreads();
    if (threadIdx.x == 0) (void)xb_add(&((unsigned*)(pk_unused.ws + OFF_BAR))[XB_XCNT(xb_xcc_id())], 1u);
#define SEAM() do { ++ph; if (ph > ph_lo && ph < ph_hi) { if (ph_hi == 0x7fffffff) gsync(grid); else { KArgP kq = (KArgP)__builtin_amdgcn_kernarg_segment_ptr(); asm volatile("" : "+s"(kq)); \
        XcdBarrier xbb; xbb.bar = (unsigned*)(kq->ws + OFF_BAR); xbb.x = xb_xcc_id(); xbb.st = xst; xcd_barrier(xbb); } } } while (0)
#define CTX() int tid = threadIdx.x; asm volatile("" : "+v"(tid)); int bid = blockIdx.x; asm volatile("" : "+s"(bid)); int G = gridDim.x; asm volatile("" : "+s"(G)); \
    KArgP kp = (KArgP)__builtin_amdgcn_kernarg_segment_ptr(); asm volatile("" : "+s"(kp)); Params p; p.x = kp->x; p.c = kp->c; p.pos = kp->pos; p.w_ada = kp->w_ada; p.b_ada = kp->b_ada; p.norm1 = kp->norm1; p.norm2 = kp->norm2; p.w_in = kp->w_in; p.ws_gmlp = kp->ws_gmlp; \
    p.bs_gmlp = kp->bs_gmlp; p.vnorm = kp->vnorm; p.w_pool = kp->w_pool; p.b_pool = kp->b_pool; p.pool_scale = kp->pool_scale; p.w_branch = kp->w_branch; p.w_out = kp->w_out; p.w_ff1 = kp->w_ff1; \
    p.w_ff2 = kp->w_ff2; p.final_norm = kp->final_norm; p.out = kp->out; p.ws = kp->ws; p.ph_lo = kp->ph_lo; p.ph_hi = kp->ph_hi; unsigned char* const wsq = p.ws; \
    const int lane = tid & 63, wave = __builtin_amdgcn_readfirstlane(tid >> 6), gtid = bid * 512 + tid, gw = bid * 8 + wave, nthr = G * 512, ngw = G * 8; \
    float* mod = (float*)(wsq + OFF_MOD); float* sumsq = (float*)(wsq + OFF_SUMSQ); (void)lane; (void)wave; (void)gtid; (void)gw; (void)nthr; (void)ngw; (void)mod; (void)sumsq;
#define LCTX() const float* xin = (l == 0) ? p.x : p.out; const float* modl = mod + (size_t)l * 8 * 6144; (void)xin; (void)modl;

    PH(0) {
        CTX();
        float* cact = (float*)shm;
        for (int i = tid; i < 8192; i += 512) { const float v = p.c[i]; cact[i] = siluf_(v); }
        __syncthreads();
        float* modpart = (float*)(p.ws + SLOTP(1));
        for (int t = gtid; t < 98304; t += nthr) {
            const int cg4 = t % 1536, rest = t / 1536, ks = rest & 31, l = rest >> 5;
            f32x4 a[8];
#pragma unroll
            for (int b = 0; b < 8; ++b) a[b] = (f32x4){0.f, 0.f, 0.f, 0.f};
            const float* w = p.w_ada + ((size_t)l * 1024 + ks * 32) * 6144 + cg4 * 4;
#pragma unroll 8
            for (int k = 0; k < 32; ++k) { const f32x4 wv = __builtin_nontemporal_load((const f32x4*)(w + (size_t)k * 6144));
#pragma unroll
                for (int b = 0; b < 8; ++b) a[b] += wv * cact[b * 1024 + ks * 32 + k]; }
#pragma unroll
            for (int b = 0; b < 8; ++b) *(f32x4*)(modpart + ((size_t)((ks * 2 + l) * 8 + b)) * 6144 + cg4 * 4) = a[b];
        }
        __syncthreads();
        conv_set(p, 0, 0, shm, gw, ngw, wave, lane);
    }
    SEAM();
    PH(0) {
        CTX();
        const float* modpart = (const float*)(p.ws + SLOTP(1));
        for (int idx = gtid; idx < 98304; idx += nthr) {
            const int l = idx / 49152, rem = idx - l * 49152, b = rem / 6144, col = rem - b * 6144;
            float s = p.b_ada[l * 6144 + col];
            for (int ks = 0; ks < 32; ++ks) s += modpart[((size_t)((ks * 2 + l) * 8 + b)) * 6144 + col];
            mod[idx] = s;
        }
    }
    SEAM();

#pragma nounroll
    for (int lq = 0; lq < 2; ++lq) {
        int l = lq; asm volatile("" : "+s"(l));
        PH(1) {
            CTX(); LCTX();
            if (l == 0) norm_rows(p.x, (bf16_t*)(p.ws + SLOTP(7)), p.norm1 + l * 1024, modl, gw, ngw, lane);
            else norm_rows_b((const bf16_t*)p.out, (bf16_t*)(p.ws + SLOTP(7)), p.norm1 + l * 1024, modl, gw, ngw, lane);
            for (int i = gtid; i < MTOK; i += nthr) sumsq[i] = 0.f;
            if (l == 1) conv_set(p, 1, 0, shm, gw, ngw, wave, lane);
        }
        SEAM();
        PH(2) {
            CTX(); LCTX();
            pg8::PlainSched S; S.so.init(64, 16, G, bid); S.A = (const char*)(p.ws + SLOTP(7)); S.B = (const char*)(p.ws + OFF_WIN); S.tA = 256 * 1024 * 2; S.tB = 256 * 1024 * 2;
            EpiIn E; E.slots = p.ws + OFF_SLOTS;
            PH(13) pg8::gemm_phase(ldsl, pg8::Gemm{1024, 1024, 1024}, S, E);
        }
        PH(2) {
            CTX(); LCTX();
            pg8::PlainSched T; T.so.init(8, 64, G, bid); T.A = (const char*)(p.ws + OFF_WIN) + (size_t)4096 * 2048; T.B = (const char*)(p.ws + SLOTP(7)); T.tA = 256 * 1024 * 2; T.tB = 256 * 1024 * 2;
            EpiInT ET; ET.vT = (bf16_t*)(p.ws + SLOTP(4)); ET.vsT = (bf16_t*)(p.ws + SLOTP(6)); ET.sumsq = sumsq;
            PH(14) pg8::gemm_phase(ldsl, pg8::Gemm{1024, 1024, 1024}, T, ET);
        }
        SEAM();
        PH(3) { CTX(); LCTX(); for (int it = bid; it < 512; it += G) sgu_item(p, l, it >> 2, it & 3, shm, tid, wave, lane); }
        PH(4) { CTX(); LCTX(); pooled_tasks(p, gtid, nthr); }
        PH(5) { CTX(); LCTX(); for (int it = bid; it < 512; it += G) kv_item(p, it, shm, tid, wave, lane); }
        __syncthreads();
        PH(1) { CTX(); LCTX(); conv_set(p, l, 1, shm, gw, ngw, wave, lane); }
        SEAM();
        PH(6) {
            CTX(); LCTX();
            PoolSched S; S.G = G; S.c = bid; S.pooled = (const char*)(p.ws + SLOTP(0)); S.wp = (const char*)(p.ws + OFF_WPOOL);
            EpiPool E; E.y = (bf16_t*)(p.ws + SLOTP(0)); E.bias = p.b_pool + l * 1024; E.scale = p.pool_scale + l * 1024;
            pg8::gemm_phase(ldsl, pg8::Gemm{1024, 256, 256}, S, E);
        }
        PH(7) { CTX(); LCTX(); scan_tasks(p, gtid, nthr); }
        SEAM();
        PH(8) { CTX(); LCTX(); for (int it = bid; it < 512; it += G) ret_item(p, it, shm, tid, wave, lane); }
        __syncthreads();
        SEAM();
        PH(9) {
            CTX(); LCTX();
            BranchSched S; S.so.init(64, 4, G, bid); S.h = (const char*)(p.ws + SLOTP(7)); S.wg = (const char*)(p.ws + OFF_WIN) + (size_t)6144 * 2048;
            S.slots = (const char*)(p.ws + OFF_SLOTS); S.wb = (const char*)(p.ws + OFF_WBR);
            EpiBranch E; E.gcur = (bf16_t*)(p.ws + SLOTP(1)); E.tmp = (bf16_t*)(p.ws + SLOTP(5)); E.merged = (bf16_t*)(p.ws + SLOTP(4));
            pg8::gemm_phase(ldsl, pg8::Gemm{1024, 1024, 1024}, S, E);
        }
        SEAM();
        PH(10) {
            CTX(); LCTX();
            pg8::PlainSched S; S.so.init(64, 4, G, bid); S.A = (const char*)(p.ws + SLOTP(4)); S.B = (const char*)(p.ws + OFF_WOUT); S.tA = 256 * 1024 * 2; S.tB = 256 * 1024 * 2;
            EpiResidB E; E.xf = p.x; E.xb = (const bf16_t*)p.out; E.xdst = (bf16_t*)p.out; E.gate = modl + 2048; E.src_f32 = (l == 0) ? 1 : 0;
            pg8::gemm_phase(ldsl, pg8::Gemm{1024, 1024, 1024}, S, E);
        }
        SEAM();
        PH(1) {
            CTX(); LCTX();
            norm_rows_b((const bf16_t*)p.out, (bf16_t*)(p.ws + SLOTP(7)), p.norm2 + l * 1024, modl + 3072, gw, ngw, lane);
            conv_set(p, l, 2, shm, gw, ngw, wave, lane);
        }
        SEAM();
        PH(11) {
            CTX(); LCTX();
            pg8::PlainSched S; S.so.init(64, 16, G, bid); S.A = (const char*)(p.ws + SLOTP(7)); S.B = (const char*)(p.ws + OFF_WFF1); S.tA = 256 * 1024 * 2; S.tB = 256 * 1024 * 2;
            EpiFF1 E; E.hid = (bf16_t*)(p.ws + SLOTP(0));
            pg8::gemm_phase(ldsl, pg8::Gemm{1024, 1024, 1024}, S, E);
        }
        SEAM();
        PH(12) {
            CTX(); LCTX();
            pg8::PlainSched S; S.so.init(64, 4, G, bid); S.A = (const char*)(p.ws + SLOTP(0)); S.B = (const char*)(p.ws + OFF_WFF2); S.tA = (size_t)256 * 4096 * 2; S.tB = (size_t)256 * 4096 * 2;
            EpiResidB E; E.xf = p.x; E.xb = (const bf16_t*)p.out; E.xdst = (l == 1) ? (bf16_t*)(p.ws + SLOTP(4)) : (bf16_t*)p.out; E.gate = modl + 5120; E.src_f32 = 0;
            pg8::gemm_phase(ldsl, pg8::Gemm{4096, 4096, 4096}, S, E);
        }
        SEAM();
    }
    if (ph >= ph_lo && ph < ph_hi) {
        CTX();
        for (int row = gw; row < MTOK; row += ngw) {
            const u32x4* xr = (const u32x4*)((const bf16_t*)(p.ws + SLOTP(4)) + (size_t)row * 1024) + lane;
            float v[2][8]; float s = 0.f;
#pragma unroll
            for (int j = 0; j < 2; ++j) { const u32x4 t = xr[64 * j];
                v[j][0] = bflo(t.x); v[j][1] = bfhi(t.x); v[j][2] = bflo(t.y); v[j][3] = bfhi(t.y); v[j][4] = bflo(t.z); v[j][5] = bfhi(t.z); v[j][6] = bflo(t.w); v[j][7] = bfhi(t.w);
#pragma unroll
                for (int k = 0; k < 8; ++k) s += v[j][k] * v[j][k]; }
            const float rstd = rsqrtf(wave_sum(s) * (1.f / 1024.f) + EPS);
            f32x4 gf[2][2];
#pragma unroll
            for (int j = 0; j < 2; ++j)
#pragma unroll
                for (int q = 0; q < 2; ++q) gf[j][q] = *(const f32x4*)(p.final_norm + (lane + 64 * j) * 8 + 4 * q);
            float* orow = p.out + (size_t)row * 1024;
#pragma unroll
            for (int j = 0; j < 2; ++j) {
                *(f32x4*)(orow + (lane + 64 * j) * 8) = (f32x4){v[j][0], v[j][1], v[j][2], v[j][3]} * rstd * gf[j][0];
                *(f32x4*)(orow + (lane + 64 * j) * 8 + 4) = (f32x4){v[j][4], v[j][5], v[j][6], v[j][7]} * rstd * gf[j][1]; }
        }
    }
}

constexpr int LDS_BYTES = 131072 + 16;

extern "C" void kernel_launch(void* const* d_in, const int* in_sizes, int n_in, void* d_out, int out_size, void* d_ws, size_t ws_size, hipStream_t stream) {
    static int grid_blocks = 0;
    if (grid_blocks == 0) {
        if (n_in != 19 || ws_size < WS_NEED) { fprintf(stderr, "kernel_launch: need 19 inputs and %zu bytes of workspace; got %d, %zu\n", (size_t)WS_NEED, n_in, ws_size); grid_blocks = -1; return; }
        int dev = 0, cus = 0, per_cu = 0;
        hipGetDevice(&dev);
        hipDeviceGetAttribute(&cus, hipDeviceAttributeMultiprocessorCount, dev);
        hipFuncSetAttribute((const void*)fwd_megakernel, hipFuncAttributeMaxDynamicSharedMemorySize, LDS_BYTES);
        hipOccupancyMaxActiveBlocksPerMultiprocessor(&per_cu, (const void*)fwd_megakernel, 512, LDS_BYTES);
        if (per_cu < 1) { fprintf(stderr, "kernel_launch: occupancy query reports %d blocks per CU\n", per_cu); per_cu = 1; }
        grid_blocks = cus;
        if (grid_blocks > 256) grid_blocks = 256;
    }
    if (grid_blocks < 0) return;
    if (hipMemsetAsync((unsigned char*)d_ws + OFF_BAR, 0, XCD_BAR_WORDS * 4, stream) != hipSuccess) { fprintf(stderr, "kernel_launch: memset of the barrier words failed\n"); return; }
    Params p{};
    p.x = (const float*)d_in[0]; p.c = (const float*)d_in[1]; p.pos = (const int*)d_in[2];
    p.w_ada = (const float*)d_in[3]; p.b_ada = (const float*)d_in[4]; p.norm1 = (const float*)d_in[5]; p.norm2 = (const float*)d_in[6];
    p.w_in = (const float*)d_in[7]; p.ws_gmlp = (const float*)d_in[8]; p.bs_gmlp = (const float*)d_in[9]; p.vnorm = (const float*)d_in[10];
    p.w_pool = (const float*)d_in[11]; p.b_pool = (const float*)d_in[12]; p.pool_scale = (const float*)d_in[13]; p.w_branch = (const float*)d_in[14];
    p.w_out = (const float*)d_in[15]; p.w_ff1 = (const float*)d_in[16]; p.w_ff2 = (const float*)d_in[17]; p.final_norm = (const float*)d_in[18];
    p.out = (float*)d_out; p.ws = (unsigned char*)d_ws;
#ifndef N_LAUNCHES
#define N_LAUNCHES 1
#endif
    for (int li = 0; li < (N_LAUNCHES == 1 ? 1 : 25); ++li) {
        if (N_LAUNCHES == 1) { p.ph_lo = 0; p.ph_hi = 1000; } else { p.ph_lo = li; p.ph_hi = li + 1; }
        void* args[] = {&p};
        hipError_t e = hipLaunchCooperativeKernel((const void*)fwd_megakernel, dim3(grid_blocks), dim3(512), args, LDS_BYTES, stream);
        if (e != hipSuccess) { fprintf(stderr, "cooperative launch failed: %s (grid %d)\n", hipGetErrorString(e), grid_blocks); break; }
    }
}
```
